# Optimizing an MI355X kernel written in HIP

```python
import math
import jax, jax.numpy as jnp
from jax import lax
import numpy as np


D_MODEL = 2048
BATCH = 4
SEQ = 8192
DEPTH = 2

EPS = 1e-6
ROPE_THETA = 10000.0

SSD_HEADS = 16
SSD_HEAD_DIM = 64
SSD_WIDTH = SSD_HEADS * SSD_HEAD_DIM
SSD_GROUPS = 2
SSD_STATE = 128
SSD_CONV = 4
SSD_CHUNK = 128
SSD_CONV_CH = SSD_WIDTH + 2 * SSD_GROUPS * SSD_STATE

ATT_HEADS = 8
ATT_HEAD_DIM = 64
ATT_WIDTH = ATT_HEADS * ATT_HEAD_DIM
DILATED_PAIRS = ((128, 1), (512, 4), (2048, 16))
ATT_BLOCK = 128

RET_HEADS = 4
RET_QK_DIM = 64
RET_V_DIM = 128
RET_QK_WIDTH = RET_HEADS * RET_QK_DIM
RET_V_WIDTH = RET_HEADS * RET_V_DIM
RET_CHUNK = 128

MIX_WIDTH = SSD_WIDTH + ATT_WIDTH + RET_V_WIDTH
IN_SPLITS = (SSD_WIDTH, SSD_CONV_CH, SSD_HEADS,
             ATT_WIDTH, ATT_WIDTH, ATT_WIDTH,
             RET_QK_WIDTH, RET_QK_WIDTH, RET_V_WIDTH, RET_V_WIDTH)
IN_WIDTH = sum(IN_SPLITS)
D_FF = ((8 * D_MODEL // 3 + 255) // 256) * 256

kernel_name = 'hybrid_ssd_dilated_retention_block'


def rms_norm(x, g):
    xf = x.astype(jnp.float32)
    y = xf * lax.rsqrt(jnp.mean(xf * xf, axis=-1, keepdims=True) + EPS)
    return (y * g.astype(jnp.float32)).astype(x.dtype)


def grouped_rms(x, groups, gain):
    b, s, w = x.shape
    xg = x.astype(jnp.float32).reshape(b, s, groups, w // groups)
    xg = xg * lax.rsqrt(jnp.mean(xg * xg, axis=-1, keepdims=True) + EPS)
    return xg.reshape(b, s, w) * gain.astype(jnp.float32)


def rope_tables(seq, dim):
    pos = jnp.arange(seq, dtype=jnp.float32)
    inv = ROPE_THETA ** (-jnp.arange(0, dim, 2, dtype=jnp.float32) / dim)
    ang = pos[:, None] * inv[None, :]
    return jnp.cos(ang), jnp.sin(ang)


def apply_rope(t, cos, sin):
    half = t.shape[-1] // 2
    t1, t2 = t[..., :half], t[..., half:]
    c = cos[None, :, None, :]
    s = sin[None, :, None, :]
    return jnp.concatenate([t1 * c - t2 * s, t1 * s + t2 * c], axis=-1)


def causal_dwconv(u, w, b):
    k = w.shape[0]
    s = u.shape[1]
    up = jnp.pad(u, ((0, 0), (k - 1, 0), (0, 0)))
    return b + sum(up[:, i:i + s] * w[i] for i in range(k))


def ssd_chunked(x, dt, a_neg, bm, cm):
    bsz, s, h, p = x.shape
    g, n = bm.shape[2], bm.shape[3]
    j = h // g
    l = SSD_CHUNK
    c = s // l
    xg = (x * dt[..., None]).reshape(bsz, c, l, g, j, p)
    da = (dt * a_neg).reshape(bsz, c, l, g, j).transpose(0, 1, 3, 4, 2)
    acum = jnp.cumsum(da, axis=-1)
    bc = bm.reshape(bsz, c, l, g, n)
    cc = cm.reshape(bsz, c, l, g, n)
    causal = jnp.tril(jnp.ones((l, l), dtype=bool))
    seg = acum[..., :, None] - acum[..., None, :]
    decay_in = jnp.exp(jnp.where(causal, seg, -jnp.inf))
    cb = jnp.einsum('bclgn,bcsgn->bcgls', cc, bc)
    y_diag = jnp.einsum('bcgjls,bcsgjp->bclgjp', cb[:, :, :, None] * decay_in, xg)
    decay_to_end = jnp.exp(acum[..., -1:] - acum)
    xw = xg * decay_to_end.transpose(0, 1, 4, 2, 3)[..., None]
    chunk_states = jnp.einsum('bclgn,bclgjp->bcgjpn', bc, xw)
    chunk_decay = jnp.exp(acum[..., -1])

    def step(state, inp):
        st_c, dec_c = inp
        return state * dec_c[..., None, None] + st_c, state

    init = jnp.zeros((bsz, g, j, p, n), jnp.float32)
    _, prev = lax.scan(step, init, (chunk_states.transpose(1, 0, 2, 3, 4, 5),
                                    chunk_decay.transpose(1, 0, 2, 3)))
    prev = prev.transpose(1, 0, 2, 3, 4, 5)
    y_off = jnp.einsum('bclgn,bcgjpn->bclgjp', cc, prev) * \
        jnp.exp(acum).transpose(0, 1, 4, 2, 3)[..., None]
    return (y_diag + y_off).reshape(bsz, s, h, p)


def dilated_branch(q, k, v, window, dilation):
    bsz, s, h, hd = q.shape
    steps = window // dilation
    blk = ATT_BLOCK
    L = s // dilation
    nb = -(-L // blk)
    pad = nb * blk - L

    def to_sub(t):
        t = t.reshape(bsz, L, dilation, h, hd).transpose(0, 2, 3, 1, 4)
        return jnp.pad(t, ((0, 0), (0, 0), (0, 0), (0, pad), (0, 0)))

    def key_blocks(t):
        t = jnp.pad(to_sub(t), ((0, 0), (0, 0), (0, 0), (blk, 0), (0, 0)))
        t = t.reshape(bsz, dilation, h, nb + 1, blk, hd)
        return jnp.concatenate([t[:, :, :, :-1], t[:, :, :, 1:]], axis=4)

    qb = to_sub(q).reshape(bsz, dilation, h, nb, blk, hd)
    kb = key_blocks(k)
    vb = key_blocks(v)
    sc = jnp.einsum('brhnqd,brhnkd->brhnqk', qb, kb).astype(jnp.float32)
    iq = jnp.arange(blk)[:, None]
    ik = jnp.arange(2 * blk)[None, :]
    dist = blk + iq - ik
    kpos = (jnp.arange(nb) * blk - blk)[:, None, None] + ik[None]
    valid = (dist >= 0) & (dist <= steps) & (kpos >= 0)
    sc = jnp.where(valid, sc, -jnp.inf)
    mx = jnp.max(sc, axis=-1, keepdims=True)
    pr = jnp.exp(sc - mx)
    den = jnp.sum(pr, axis=-1, keepdims=True)
    out = jnp.einsum('brhnqk,brhnkd->brhnqd', pr, vb.astype(jnp.float32)) / den
    lse = (mx + jnp.log(den))[..., 0]

    def from_sub(t):
        t = t.reshape(bsz, dilation, h, nb * blk, *t.shape[5:])[:, :, :, :L]
        t = jnp.moveaxis(t, 3, 1)
        return t.reshape(bsz, s, h, *t.shape[4:])

    return from_sub(out), from_sub(lse)


def retention_chunked(q, k, v):
    bsz, s, h, dk = q.shape
    dv = v.shape[-1]
    l = RET_CHUNK
    c = s // l
    log_gamma = jnp.log1p(-jnp.exp2(-5.0 - jnp.arange(h, dtype=jnp.float32)))
    idx = jnp.arange(l, dtype=jnp.float32)
    rel = idx[:, None] - idx[None, :]
    decay_in = jnp.where(rel >= 0,
                         jnp.exp(jnp.maximum(rel, 0.0)[None] * log_gamma[:, None, None]),
                         0.0)
    qc = q.reshape(bsz, c, l, h, dk)
    kc = k.reshape(bsz, c, l, h, dk)
    vc = v.reshape(bsz, c, l, h, dv)
    scores = jnp.einsum('bclhd,bcshd->bchls', qc, kc) * decay_in
    inner = jnp.einsum('bchls,bcshe->bclhe', scores, vc)
    k_to_end = jnp.exp((l - 1 - idx)[:, None] * log_gamma[None, :])
    kv = jnp.einsum('bclhd,bclhe->bchde', kc * k_to_end[:, :, None], vc)
    chunk_decay = jnp.exp(l * log_gamma)

    def step(state, kv_c):
        return state * chunk_decay[:, None, None] + kv_c, state

    init = jnp.zeros((bsz, h, dk, dv), jnp.float32)
    _, prev = lax.scan(step, init, kv.transpose(1, 0, 2, 3, 4))
    prev = prev.transpose(1, 0, 2, 3, 4)
    q_from_start = jnp.exp((idx + 1.0)[:, None] * log_gamma[None, :])
    cross = jnp.einsum('bclhd,bchde->bclhe', qc * q_from_start[:, :, None], prev)
    return (inner + cross).reshape(bsz, s, h, dv)


def hybrid_mixer(hn, w_in, conv_w, conv_b, dt_bias, a_log, d_skip, ssd_norm,
                 q_norm, k_norm, ret_norm, w_out, cos, sin):
    bsz, s, _ = hn.shape
    f32 = jnp.float32
    proj = (hn @ w_in).astype(f32)
    cuts = list(np.cumsum(IN_SPLITS)[:-1])
    z, xbc, dt_raw, aq, ak, av, rq, rk, rv, rg = jnp.split(proj, cuts, axis=-1)

    xbc = jax.nn.silu(causal_dwconv(xbc, conv_w.astype(f32), conv_b.astype(f32)))
    xs, bm, cm = jnp.split(xbc, [SSD_WIDTH, SSD_WIDTH + SSD_GROUPS * SSD_STATE], axis=-1)
    xs = xs.reshape(bsz, s, SSD_HEADS, SSD_HEAD_DIM)
    bm = bm.reshape(bsz, s, SSD_GROUPS, SSD_STATE)
    cm = cm.reshape(bsz, s, SSD_GROUPS, SSD_STATE)
    dt = jax.nn.softplus(dt_raw + dt_bias.astype(f32))
    a_neg = -jnp.exp(a_log.astype(f32))
    y_ssd = ssd_chunked(xs, dt, a_neg, bm, cm) + xs * d_skip.astype(f32)[:, None]
    y_ssd = grouped_rms(y_ssd.reshape(bsz, s, SSD_WIDTH) * jax.nn.silu(z), SSD_GROUPS, ssd_norm)

    aq = apply_rope(rms_norm(aq.reshape(bsz, s, ATT_HEADS, ATT_HEAD_DIM), q_norm), cos, sin)
    aq = aq * (ATT_HEAD_DIM ** -0.5)
    ak = apply_rope(rms_norm(ak.reshape(bsz, s, ATT_HEADS, ATT_HEAD_DIM), k_norm), cos, sin)
    av = av.reshape(bsz, s, ATT_HEADS, ATT_HEAD_DIM)
    branches = [dilated_branch(aq, ak, av, w, d) for (w, d) in DILATED_PAIRS]
    outs = jnp.stack([o for o, _ in branches])
    wts = jax.nn.softmax(jnp.stack([lse for _, lse in branches]), axis=0)
    y_att = jnp.sum(wts[..., None] * outs, axis=0).reshape(bsz, s, ATT_WIDTH)

    rq = apply_rope(rq.reshape(bsz, s, RET_HEADS, RET_QK_DIM), cos, sin)
    rk = apply_rope(rk.reshape(bsz, s, RET_HEADS, RET_QK_DIM), cos, sin) * (RET_QK_DIM ** -0.5)
    rv = rv.reshape(bsz, s, RET_HEADS, RET_V_DIM)
    y_ret = retention_chunked(rq, rk, rv).reshape(bsz, s, RET_V_WIDTH)
    y_ret = grouped_rms(y_ret, RET_HEADS, ret_norm) * jax.nn.silu(rg)

    y = jnp.concatenate([y_ssd, y_att, y_ret], axis=-1).astype(hn.dtype)
    return y @ w_out


def swiglu(hn, w_gate, w_up, w_down):
    return (jax.nn.silu(hn @ w_gate) * (hn @ w_up)) @ w_down


def setup_inputs(seed: int = 0) -> dict:
    key = jax.random.key(seed)
    ks = jax.random.split(key, 17)
    f32 = jnp.float32

    def nrm(k, shape, scale):
        return jax.random.normal(k, shape, f32) * scale

    x = nrm(ks[0], (BATCH, SEQ, D_MODEL), 1.0)
    ln_mix = 1.0 + nrm(ks[1], (DEPTH, D_MODEL), 0.02)
    w_in = nrm(ks[2], (DEPTH, D_MODEL, IN_WIDTH), D_MODEL ** -0.5)
    conv_w = nrm(ks[3], (DEPTH, SSD_CONV, SSD_CONV_CH), SSD_CONV ** -0.5)
    conv_b = nrm(ks[4], (DEPTH, SSD_CONV_CH), 0.01)
    dt0 = jnp.exp(jax.random.uniform(ks[5], (DEPTH, SSD_HEADS), f32,
                                     math.log(1e-3), math.log(1e-1)))
    dt_bias = dt0 + jnp.log(-jnp.expm1(-dt0))
    a_log = jnp.log(jax.random.uniform(ks[6], (DEPTH, SSD_HEADS), f32, 1.0, 16.0))
    d_skip = 1.0 + nrm(ks[7], (DEPTH, SSD_HEADS), 0.1)
    ssd_norm = 1.0 + nrm(ks[8], (DEPTH, SSD_WIDTH), 0.02)
    q_norm = 1.0 + nrm(ks[9], (DEPTH, ATT_HEAD_DIM), 0.02)
    k_norm = 1.0 + nrm(ks[10], (DEPTH, ATT_HEAD_DIM), 0.02)
    ret_norm = 1.0 + nrm(ks[11], (DEPTH, RET_V_WIDTH), 0.02)
    w_out = nrm(ks[12], (DEPTH, MIX_WIDTH, D_MODEL), MIX_WIDTH ** -0.5)
    ln_ffn = 1.0 + nrm(ks[13], (DEPTH, D_MODEL), 0.02)
    w_gate = nrm(ks[14], (DEPTH, D_MODEL, D_FF), D_MODEL ** -0.5)
    w_up = nrm(ks[15], (DEPTH, D_MODEL, D_FF), D_MODEL ** -0.5)
    w_down = nrm(ks[16], (DEPTH, D_FF, D_MODEL), D_FF ** -0.5)
    return {'x': x, 'ln_mix': ln_mix, 'w_in': w_in, 'conv_w': conv_w, 'conv_b': conv_b,
            'dt_bias': dt_bias, 'a_log': a_log, 'd_skip': d_skip, 'ssd_norm': ssd_norm,
            'q_norm': q_norm, 'k_norm': k_norm, 'ret_norm': ret_norm, 'w_out': w_out,
            'ln_ffn': ln_ffn, 'w_gate': w_gate, 'w_up': w_up, 'w_down': w_down}


def reference(x, ln_mix, w_in, conv_w, conv_b, dt_bias, a_log, d_skip, ssd_norm,
              q_norm, k_norm, ret_norm, w_out, ln_ffn, w_gate, w_up, w_down):
    cos, sin = rope_tables(x.shape[1], ATT_HEAD_DIM)
    for i in range(DEPTH):
        x = x + hybrid_mixer(rms_norm(x, ln_mix[i]), w_in[i], conv_w[i], conv_b[i],
                             dt_bias[i], a_log[i], d_skip[i], ssd_norm[i],
                             q_norm[i], k_norm[i], ret_norm[i], w_out[i], cos, sin)
        x = x + swiglu(rms_norm(x, ln_ffn[i]), w_gate[i], w_up[i], w_down[i])
    return x
```

```cpp
#include <hip/hip_runtime.h>
#include <hip/hip_cooperative_groups.h>
#include <cstdio>
namespace cg = cooperative_groups;
namespace pg8 {
#define PG8_LAS __attribute__((address_space(3)))
typedef unsigned short bf16_t;
typedef short bf16x8 __attribute__((ext_vector_type(8)));
typedef float f32x4 __attribute__((ext_vector_type(4)));
typedef unsigned u32x4 __attribute__((ext_vector_type(4)));
constexpr int BM = 256, BK = 64, HALF = 128, HTB = HALF * BK * 2  , STAGE_BYTES = 8 * HTB, NXCD = 8, WGM = 8;

__host__ __device__ __forceinline__ int lds_byte(int r, int c) { const int st = (r >> 4) * 2 + (c >> 5), rr = r & 15, cc = c & 31, ob = rr * 64 + cc * 2; return st * 1024 + (ob ^ (((ob >> 9) & 1) << 5)); }
__host__ __device__ __forceinline__ void stage_rc(int b, int& R, int& C) { const int st = b / 1024, sb = b % 1024, swz = sb ^ (((sb >> 9) & 1) << 5); R = (st >> 1) * 16 + swz / 64; C = (st & 1) * 32 + (swz % 64) / 2; }
__host__ __device__ __forceinline__ int perm32(int rho) { const int n = rho >> 4, i = rho & 15; return 8 * (i >> 2) + 4 * n + (i & 3); }

struct Unit { int pm, pn; };
struct Gemm { const bf16_t* A; const bf16_t* Bt; int M, N, K; };

struct StaticOrder {
    int nM, nN, nwg, G, c;
    __host__ __device__ void init(int M, int N, int G_, int c_) { nM = M / BM; nN = N / BM; nwg = nM * nN; G = G_; c = c_; }
    __host__ __device__ bool next(int i, Unit& u) const {
        const long L = (long)i * G + c; if (L >= nwg) return false;
        int wgid = (int)L; { const int q = nwg / NXCD, r = nwg % NXCD, xcd = wgid % NXCD, off = wgid / NXCD; wgid = (xcd < r ? xcd * (q + 1) : r * (q + 1) + (xcd - r) * q) + off; }
        const int nig = WGM * nN, gid = wgid / nig, fm = gid * WGM, gsz = (nM - fm) < WGM ? (nM - fm) : WGM;
        u.pm = fm + ((wgid % nig) % gsz); u.pn = (wgid % nig) / gsz; return true;
    }
    __device__ __forceinline__ void a_ready(const Unit&) const {}
    __device__ __forceinline__ void done(const Unit&) const {}
};
__device__ __forceinline__ unsigned cvt_pk_bf16(float lo, float hi) { unsigned r; asm volatile("v_cvt_pk_bf16_f32 %0, %1, %2" : "=v"(r) : "v"(lo), "v"(hi)); return r; }
struct EpiProj {
    static constexpr bool PERM = true, AFTER_DRAIN = false;
    bf16_t* O; int ldc;
    __device__ __forceinline__ void operator()(const f32x4 (&acc)[2][2][4][2], const Unit& u, int wr, int wc, int fr, int fq) const {
        const int row0 = u.pm * BM + wr * 64 + fr, col0 = u.pn * BM + wc * 32 + 8 * fq;
#pragma unroll
        for (int ai = 0; ai < 2; ++ai)
#pragma unroll
            for (int m = 0; m < 4; ++m) { bf16_t* rowp = O + (size_t)(row0 + ai * HALF + m * 16) * ldc + col0;
#pragma unroll
                for (int bj = 0; bj < 2; ++bj) { const f32x4 v0 = acc[ai][bj][m][0], v1 = acc[ai][bj][m][1];
                    u32x4 w; w.x = cvt_pk_bf16(v0[0], v0[1]); w.y = cvt_pk_bf16(v0[2], v0[3]); w.z = cvt_pk_bf16(v1[0], v1[1]); w.w = cvt_pk_bf16(v1[2], v1[3]);
                    *(u32x4*)(rowp + bj * HALF) = w; } }
    }
};
struct EpiRes {
    static constexpr bool PERM = false, AFTER_DRAIN = false;
    float* C; const float* R; int ldc;
    __device__ __forceinline__ void operator()(const f32x4 (&acc)[2][2][4][2], const Unit& u, int wr, int wc, int fr, int fq) const {
        const int row0 = u.pm * BM + wr * 64 + fr, col0 = u.pn * BM + wc * 32 + 4 * fq;
#pragma unroll
        for (int ai = 0; ai < 2; ++ai)
#pragma unroll
            for (int m = 0; m < 4; ++m) { const size_t ro = (size_t)(row0 + ai * HALF + m * 16) * ldc + col0;
#pragma unroll
                for (int bj = 0; bj < 2; ++bj)
#pragma unroll
                    for (int n = 0; n < 2; ++n) { const f32x4 r = *(const f32x4*)(R + ro + bj * HALF + n * 16); *(f32x4*)(C + ro + bj * HALF + n * 16) = acc[ai][bj][m][n] + r; } }
    }
};
__device__ __forceinline__ float silu_f(float v) { return v / (1.0f + __expf(-v)); }
struct EpiSwiGLU {
    static constexpr bool PERM = true, AFTER_DRAIN = false;
    bf16_t* H; int ldc;
    __device__ __forceinline__ void operator()(const f32x4 (&acc)[2][2][4][2], const Unit& u, int wr, int wc, int fr, int fq) const {
        const int row0 = u.pm * BM + wr * 64 + fr, col0 = u.pn * HALF + wc * 32 + 8 * fq;
#pragma unroll
        for (int ai = 0; ai < 2; ++ai)
#pragma unroll
            for (int m = 0; m < 4; ++m) { bf16_t* rowp = H + (size_t)(row0 + ai * HALF + m * 16) * ldc + col0;
                f32x4 v0, v1;
#pragma unroll
                for (int j = 0; j < 4; ++j) { v0[j] = silu_f(acc[ai][0][m][0][j]) * acc[ai][1][m][0][j]; v1[j] = silu_f(acc[ai][0][m][1][j]) * acc[ai][1][m][1][j]; }
                u32x4 w; w.x = cvt_pk_bf16(v0[0], v0[1]); w.y = cvt_pk_bf16(v0[2], v0[3]); w.z = cvt_pk_bf16(v1[0], v1[1]); w.w = cvt_pk_bf16(v1[2], v1[3]);
                *(u32x4*)rowp = w; }
    }
};

template <class Epi, class Sched, bool STAMP = false>
__device__ __forceinline__ void gemm_phase(PG8_LAS unsigned char* lds, const Gemm g, const Sched& S, const Epi& E, unsigned long long* stamps) {
    int tid0_ = threadIdx.x; asm volatile("" : "+v"(tid0_)); const int tid = tid0_, wid = __builtin_amdgcn_readfirstlane(tid >> 6), lane = tid & 63, wr = wid >> 2, wc = wid & 3, fr = lane & 15, fq = lane >> 4;
    const int K = g.K, nt = K / BK;
    int ts_lo = 0, ts_hi = 0, nts = 0; const unsigned long long rt_entry = STAMP ? (unsigned long long)wall_clock64() : 0ull;
#define PG8_STAMP() do { if (STAMP && wid == 0 && nts < 64) { const unsigned long long _c = (unsigned long long)clock64(); \
        ts_lo = (lane == nts) ? (int)(unsigned)_c : ts_lo; ts_hi = (lane == nts) ? (int)(unsigned)(_c >> 32) : ts_hi; ++nts; } } while (0)
    PG8_STAMP();
    unsigned voffA[2], voffB[2];
#pragma unroll
    for (int i = 0; i < 2; ++i) { int R, C; stage_rc(tid * 16 + i * 8192, R, C); const int Rb = Epi::PERM ? ((R & ~31) + perm32(R & 31)) : R;
        voffA[i] = (unsigned)(R * K + C) * 2u; voffB[i] = (unsigned)(Rb * K + C) * 2u; }
    const size_t kstep = (size_t)(BK * 2);
    const size_t hstep = (size_t)HALF * K * 2;
    const size_t tstep = 2 * hstep;
    const unsigned ldsw = (unsigned)wid * 1024u;
    const int aoff = lds_byte(wr * 64 + fr, fq * 8), boff = lds_byte(wc * 32 + fr, fq * 8);
#define PG8_SA(b, h) (((b) * 2 + (h)) * HTB)
#define PG8_SB(b, h) ((4 + (b) * 2 + (h)) * HTB)
#define PG8_STAGE(bufoff, gbase, voff) do { _Pragma("unroll") for (int _i = 0; _i < 2; ++_i) \
        __builtin_amdgcn_global_load_lds((const unsigned*)((const char*)(gbase) + (voff)[_i]), (PG8_LAS unsigned*)(lds + (bufoff) + ldsw + _i * 8192), 16, 0, 0); } while (0)
#define PG8_LDA(dst, b, h) do { _Pragma("unroll") for (int m = 0; m < 4; ++m) _Pragma("unroll") for (int k = 0; k < 2; ++k) dst[m][k] = *(const PG8_LAS bf16x8*)(lds + PG8_SA(b, h) + aoff + m * 2048 + k * 1024); } while (0)
#define PG8_LDB(dst, b, h) do { _Pragma("unroll") for (int n = 0; n < 2; ++n) _Pragma("unroll") for (int k = 0; k < 2; ++k) dst[n][k] = *(const PG8_LAS bf16x8*)(lds + PG8_SB(b, h) + boff + n * 2048 + k * 1024); } while (0)
#define PG8_MMA(ai, bj, At, Bt) do { __builtin_amdgcn_s_setprio(1); _Pragma("unroll") for (int m = 0; m < 4; ++m) _Pragma("unroll") for (int n = 0; n < 2; ++n) _Pragma("unroll") for (int k = 0; k < 2; ++k) \
        acc[ai][bj][m][n] = __builtin_amdgcn_mfma_f32_16x16x32_bf16(Bt[n][k], At[m][k], acc[ai][bj][m][n], 0, 0, 0); __builtin_amdgcn_s_setprio(0); } while (0)
#define PG8_WAIT_V(n) asm volatile("s_waitcnt vmcnt(" #n ")" ::: "memory")
#define PG8_WAIT_L(n) asm volatile("s_waitcnt lgkmcnt(" #n ")" ::: "memory")
#define PG8_BAR __builtin_amdgcn_s_barrier()
#define PG8_SCHED __builtin_amdgcn_sched_barrier(0)
    Unit cur, nxt; int ui = 0;
    if (!S.next(0, cur)) return;
    f32x4 acc[2][2][4][2];
#pragma unroll
    for (int a = 0; a < 2; ++a)
#pragma unroll
        for (int b = 0; b < 2; ++b)
#pragma unroll
            for (int m = 0; m < 4; ++m)
#pragma unroll
                for (int n = 0; n < 2; ++n) acc[a][b][m][n] = (f32x4){0.f, 0.f, 0.f, 0.f};
    bf16x8 At[4][2], B0[2][2], B1[2][2];
    const char* cA = (const char*)g.A + (size_t)cur.pm * tstep; const char* cB = (const char*)g.Bt + (size_t)cur.pn * tstep;
    S.a_ready(cur);
    PG8_STAGE(PG8_SB(0, 0), cB, voffB); PG8_STAGE(PG8_SA(0, 0), cA, voffA); PG8_STAGE(PG8_SB(0, 1), cB + hstep, voffB); PG8_STAGE(PG8_SA(0, 1), cA + hstep, voffA);
    if (wr == 1) PG8_BAR;
    PG8_WAIT_V(4); PG8_BAR;
    PG8_STAGE(PG8_SB(1, 0), cB + kstep, voffB); PG8_STAGE(PG8_SA(1, 0), cA + kstep, voffA); PG8_STAGE(PG8_SB(1, 1), cB + hstep + kstep, voffB);
    PG8_WAIT_V(6); PG8_BAR;
    PG8_STAMP();
    for (;;) {
        const bool has_next = S.next(ui + 1, nxt);
        const char* nA = has_next ? (const char*)g.A + (size_t)nxt.pm * tstep : cA; const char* nB = has_next ? (const char*)g.Bt + (size_t)nxt.pn * tstep : cB;
        for (int t = 0; t < nt; t += 2) {
            const bool last = (t == nt - 2);
            const char* a1 = cA + (size_t)(t + 1) * kstep;
            const char* a2 = last ? nA : cA + (size_t)(t + 2) * kstep; const char* b2 = last ? nB : cB + (size_t)(t + 2) * kstep;
            const char* a3 = a2 + kstep; const char* b3 = b2 + kstep;
            if (last && has_next) S.a_ready(nxt);
            PG8_LDB(B0, 0, 0); PG8_SCHED; PG8_LDA(At, 0, 0); PG8_STAGE(PG8_SA(1, 1), a1 + hstep, voffA);
            PG8_WAIT_L(8); PG8_BAR; PG8_WAIT_L(0); PG8_MMA(0, 0, At, B0); PG8_BAR; PG8_SCHED;
            PG8_LDB(B1, 0, 1); PG8_STAGE(PG8_SB(0, 0), b2, voffB);
            PG8_BAR; PG8_WAIT_L(0); PG8_MMA(0, 1, At, B1); PG8_BAR;
            PG8_LDA(At, 0, 1); PG8_STAGE(PG8_SA(0, 0), a2, voffA);
            PG8_BAR; PG8_WAIT_L(0); PG8_MMA(1, 0, At, B0); PG8_BAR; PG8_SCHED;
            PG8_STAGE(PG8_SB(0, 1), b2 + hstep, voffB);
            PG8_WAIT_V(6); PG8_BAR; PG8_MMA(1, 1, At, B1); PG8_BAR;
            PG8_LDB(B0, 1, 0); PG8_SCHED; PG8_LDA(At, 1, 0); PG8_STAGE(PG8_SA(0, 1), a2 + hstep, voffA);
            PG8_WAIT_L(8); PG8_BAR; PG8_WAIT_L(0); PG8_MMA(0, 0, At, B0); PG8_BAR; PG8_SCHED;
            PG8_LDB(B1, 1, 1); PG8_STAGE(PG8_SB(1, 0), b3, voffB);
            PG8_BAR; PG8_WAIT_L(0); PG8_MMA(0, 1, At, B1); PG8_BAR;
            PG8_LDA(At, 1, 1); PG8_STAGE(PG8_SA(1, 0), a3, voffA);
            PG8_BAR; PG8_WAIT_L(0); PG8_MMA(1, 0, At, B0); PG8_BAR; PG8_SCHED;
            PG8_STAGE(PG8_SB(1, 1), b3 + hstep, voffB);
            PG8_WAIT_V(6); PG8_BAR; PG8_MMA(1, 1, At, B1); PG8_BAR;
        }
        PG8_STAMP();
        if constexpr (!Epi::AFTER_DRAIN) { E(acc, cur, wr, wc, fr, fq); S.done(cur); }
        PG8_STAMP();
        if (!has_next) break;
#pragma unroll
        for (int a = 0; a < 2; ++a)
#pragma unroll
            for (int b = 0; b < 2; ++b)
#pragma unroll
                for (int m = 0; m < 4; ++m)
#pragma unroll
                    for (int n = 0; n < 2; ++n) acc[a][b][m][n] = (f32x4){0.f, 0.f, 0.f, 0.f};
        cur = nxt; cA = nA; cB = nB; ++ui;
    }
    PG8_WAIT_V(0);
    if (wr == 0) PG8_BAR;
    PG8_BAR;
    if constexpr (Epi::AFTER_DRAIN) { E.fused(acc, cur, wr, wc, fr, fq, lds, wid, lane); S.done(cur); }
    PG8_STAMP();
    if (STAMP && wid == 0) { stamps[lane] = lane < nts ? (((unsigned long long)(unsigned)ts_hi << 32) | (unsigned)ts_lo) : 0ull;
        if (lane == 62) stamps[62] = rt_entry; if (lane == 63) stamps[63] = (unsigned long long)wall_clock64(); }
#undef PG8_STAMP
#undef PG8_SA
#undef PG8_SB
#undef PG8_STAGE
#undef PG8_LDA
#undef PG8_LDB
#undef PG8_MMA
#undef PG8_WAIT_V
#undef PG8_WAIT_L
#undef PG8_BAR
#undef PG8_SCHED
}
}

using pg8::bf16_t; using pg8::bf16x8; using pg8::f32x4; using pg8::cvt_pk_bf16; using pg8::silu_f;
typedef short bf16x4 __attribute__((ext_vector_type(4)));

constexpr int NTOK = 32768, DM = 2048, SEQ = 8192, LDP = 5632, DFF = 5632, INW = 5648;
constexpr int PXBC = 1024, PAQ = 2560, PAK = 3072, PAV = 3584, PRQ = 4096, PRK = 4352, PRV = 4608, PRG = 5120;
constexpr int LDS_BYTES = 131072;

constexpr size_t SZ_WIN = (size_t)5632 * 2048 * 2, SZ_WOUT = (size_t)2048 * 2048 * 2, SZ_WGU = (size_t)11264 * 2048 * 2, SZ_WDN = (size_t)2048 * 5632 * 2;
constexpr size_t OFF_WIN = 0, OFF_WOUT = OFF_WIN + 2 * SZ_WIN, OFF_WGU = OFF_WOUT + 2 * SZ_WOUT, OFF_WDN = OFF_WGU + 2 * SZ_WGU;
constexpr size_t OFF_HN = OFF_WDN + 2 * SZ_WDN;
constexpr size_t OFF_Y = OFF_HN + (size_t)NTOK * DM * 2;
constexpr size_t OFF_PROJ = OFF_Y + (size_t)NTOK * DM * 2;
constexpr size_t OFF_SST = OFF_PROJ + (size_t)NTOK * LDP * 2;
constexpr size_t OFF_RST = OFF_SST + (size_t)4096 * 8192 * 2;
constexpr size_t OFF_LSE = OFF_RST + (size_t)1024 * 8192 * 4;
constexpr size_t OFF_DT = OFF_LSE + (size_t)3 * NTOK * 8 * 4;
constexpr size_t OFF_CDEC = OFF_DT + (size_t)NTOK * 16 * 4;
constexpr size_t OFF_ROPE = OFF_CDEC + (size_t)4096 * 4;
constexpr size_t WS_END = OFF_ROPE + (size_t)8192 * 32 * 4 * 2;

struct Params {
    const float *x, *ln_mix, *w_in, *conv_w, *conv_b, *dt_bias, *a_log, *d_skip, *ssd_norm, *q_norm, *k_norm, *ret_norm, *w_out, *ln_ffn, *w_gate, *w_up, *w_down;
    float* out;
    unsigned char* ws;
};

__device__ __forceinline__ bf16x8 as_bf8(uint4 v) { return __builtin_bit_cast(bf16x8, v); }
__device__ __forceinline__ bf16x8 cat4(bf16x4 a, bf16x4 b) { return __builtin_shufflevector(a, b, 0, 1, 2, 3, 4, 5, 6, 7); }
__device__ __forceinline__ uint4 pack8u(const float* v) { uint4 w; w.x = cvt_pk_bf16(v[0], v[1]); w.y = cvt_pk_bf16(v[2], v[3]); w.z = cvt_pk_bf16(v[4], v[5]); w.w = cvt_pk_bf16(v[6], v[7]); return w; }
__device__ __forceinline__ uint2 pack4u(float a, float b, float c, float d) { uint2 w; w.x = cvt_pk_bf16(a, b); w.y = cvt_pk_bf16(c, d); return w; }
__device__ __forceinline__ void unpack8(uint4 r, float* v) {
    v[0] = __uint_as_float(r.x << 16); v[1] = __uint_as_float(r.x & 0xffff0000u); v[2] = __uint_as_float(r.y << 16); v[3] = __uint_as_float(r.y & 0xffff0000u);
    v[4] = __uint_as_float(r.z << 16); v[5] = __uint_as_float(r.z & 0xffff0000u); v[6] = __uint_as_float(r.w << 16); v[7] = __uint_as_float(r.w & 0xffff0000u); }
__device__ __forceinline__ void unpack4(uint2 r, float* v) {
    v[0] = __uint_as_float(r.x << 16); v[1] = __uint_as_float(r.x & 0xffff0000u); v[2] = __uint_as_float(r.y << 16); v[3] = __uint_as_float(r.y & 0xffff0000u); }
__device__ __forceinline__ bf16_t f2bf(float f) { return (bf16_t)(cvt_pk_bf16(f, 0.f) & 0xffffu); }
__device__ __forceinline__ f32x4 mfma16(bf16x8 a, bf16x8 b, f32x4 c) { return __builtin_amdgcn_mfma_f32_16x16x32_bf16(a, b, c, 0, 0, 0); }
#define F4ZERO ((f32x4){0.f, 0.f, 0.f, 0.f})

__device__ __forceinline__ void wt_tile(const float* __restrict__ src, int ld, int k0, int col0, bf16_t* dst, int ldd, int row0, float* t) {
    const int tid = threadIdx.x;
    { const int nn = tid & 63, kk0 = tid >> 6;
#pragma unroll
      for (int i = 0; i < 8; ++i) { const int kk = kk0 + 8 * i; t[kk * 65 + nn] = src[(size_t)(k0 + kk) * ld + col0 + nn]; } }
    __syncthreads();
    { const int kk = (tid & 31) * 2, nn0 = tid >> 5;
#pragma unroll
      for (int i = 0; i < 4; ++i) { const int nn = nn0 + 16 * i; *(unsigned*)(dst + (size_t)(row0 + nn) * ldd + k0 + kk) = cvt_pk_bf16(t[kk * 65 + nn], t[(kk + 1) * 65 + nn]); } }
    __syncthreads();
}
__device__ __forceinline__ void phase_prep(const Params& p, unsigned char* shm) {
    float* t = (float*)shm;
    for (int id = blockIdx.x; id < 2 * 12288; id += gridDim.x) {
        const int layer = id / 12288; int r = id - layer * 12288;
        if (r < 2816) { const int kt = r / 88, nt = r - kt * 88, n0 = nt * 64;
            wt_tile(p.w_in + (size_t)layer * DM * INW, INW, kt * 64, n0 < 2560 ? n0 : n0 + 16, (bf16_t*)(p.ws + OFF_WIN + layer * SZ_WIN), DM, n0, t); }
        else if ((r -= 2816) < 1024) { const int kt = r >> 5, nt = r & 31;
            wt_tile(p.w_out + (size_t)layer * DM * DM, DM, kt * 64, nt * 64, (bf16_t*)(p.ws + OFF_WOUT + layer * SZ_WOUT), DM, nt * 64, t); }
        else if ((r -= 1024) < 5632) { const int kt = r / 176, nt = r - kt * 176, n0 = nt * 64, pn = n0 >> 8, bj = (n0 >> 7) & 1, j0 = n0 & 127;
            wt_tile((bj ? p.w_up : p.w_gate) + (size_t)layer * DM * DFF, DFF, kt * 64, pn * 128 + j0, (bf16_t*)(p.ws + OFF_WGU + layer * SZ_WGU), DM, n0, t); }
        else { r -= 5632; const int kt = r >> 5, nt = r & 31;
            wt_tile(p.w_down + (size_t)layer * DFF * DM, DM, kt * 64, nt * 64, (bf16_t*)(p.ws + OFF_WDN + layer * SZ_WDN), DFF, nt * 64, t); }
    }
    float* cosT = (float*)(p.ws + OFF_ROPE); float* sinT = cosT + 8192 * 32;
    for (int e = blockIdx.x * 512 + threadIdx.x; e < 8192 * 32; e += gridDim.x * 512) {
        const int pos = e >> 5, i = e & 31;
        const float inv = (float)exp(-(double)i * (9.210340371976184 / 32.0));
        const float ang = (float)pos * inv;
        const double rev = (double)ang * 0.15915494309189535; const float fr = (float)(rev - rint(rev));
        cosT[e] = __builtin_amdgcn_cosf(fr); sinT[e] = __builtin_amdgcn_sinf(fr);
    }
}

template <bool WITH_DT>
__device__ __forceinline__ void phase_norm(const float* __restrict__ xin, const float* __restrict__ g, bf16_t* hn, const float* w_in_l, const float* dt_bias, float* dtbuf, unsigned char* shm) {
    int tid0_ = threadIdx.x; asm volatile("" : "+v"(tid0_)); const int tid = tid0_, lane = tid & 63, wid = tid >> 6;
    float* wl = (float*)shm;
    if (WITH_DT) {
        for (int k = tid; k < 2048; k += 512) {
            const float4* s = (const float4*)(w_in_l + (size_t)k * INW + 2560);
#pragma unroll
            for (int q = 0; q < 4; ++q) { const float4 v = s[q]; wl[(4 * q + 0) * 2048 + k] = v.x; wl[(4 * q + 1) * 2048 + k] = v.y; wl[(4 * q + 2) * 2048 + k] = v.z; wl[(4 * q + 3) * 2048 + k] = v.w; } }
        __syncthreads();
    }
    float4 gg[8];
#pragma unroll
    for (int i = 0; i < 8; ++i) gg[i] = *(const float4*)(g + i * 256 + lane * 4);
    for (int row = blockIdx.x * 8 + wid; row < NTOK; row += gridDim.x * 8) {
        float4 v[8]; float ss = 0.f;
#pragma unroll
        for (int i = 0; i < 8; ++i) { v[i] = *(const float4*)(xin + (size_t)row * DM + i * 256 + lane * 4); ss += v[i].x * v[i].x + v[i].y * v[i].y + v[i].z * v[i].z + v[i].w * v[i].w; }
#pragma unroll
        for (int o = 32; o >= 1; o >>= 1) ss += __shfl_xor(ss, o);
        const float rstd = rsqrtf(ss * (1.0f / DM) + 1e-6f);
#pragma unroll
        for (int i = 0; i < 8; ++i) { v[i].x *= rstd * gg[i].x; v[i].y *= rstd * gg[i].y; v[i].z *= rstd * gg[i].z; v[i].w *= rstd * gg[i].w;
            *(uint2*)(hn + (size_t)row * DM + i * 256 + lane * 4) = pack4u(v[i].x, v[i].y, v[i].z, v[i].w); }
        if (WITH_DT) {
            float res = 0.f;
#pragma unroll
            for (int j = 0; j < 16; ++j) { float a = 0.f;
#pragma unroll
                for (int i = 0; i < 8; ++i) { const float4 w4 = *(const float4*)(wl + j * 2048 + i * 256 + lane * 4); a += v[i].x * w4.x + v[i].y * w4.y + v[i].z * w4.z + v[i].w * w4.w; }
#pragma unroll
                for (int o = 32; o >= 1; o >>= 1) a += __shfl_xor(a, o);
                res = (lane == j) ? a : res; }
            if (lane < 16) { const float xv = res + dt_bias[lane]; dtbuf[(size_t)row * 16 + lane] = fmaxf(xv, 0.f) + log1pf(__expf(-fabsf(xv))); }
        }
    }
    __syncthreads();
}

template <class Epi>
__device__ __forceinline__ void run_gemm(unsigned char* shm, const bf16_t* A, const bf16_t* Bt, int M, int N, int K, const Epi& E) {
    pg8::Gemm g; g.A = A; g.Bt = Bt; g.M = M; g.N = N; g.K = K;
    pg8::StaticOrder S; S.init(M, N, (int)gridDim.x, (int)blockIdx.x);
    pg8::gemm_phase<Epi, pg8::StaticOrder, false>((PG8_LAS unsigned char*)shm, g, S, E, nullptr);
    __syncthreads();
}

template <bool TRANS>
__device__ __forceinline__ void stage_conv(const bf16_t* __restrict__ proj, const float* __restrict__ cw, const float* __restrict__ cb, size_t tokbase, int tpos0, int ch0, int W, bf16_t* dst, int stride, const float* rs) {
    const int tid = threadIdx.x, l = tid & 127, cgi = tid >> 7;
    const float scale = rs ? rs[l] : 1.0f;
    for (int c8 = cgi * 8; c8 < W; c8 += 32) {
        const int ch = ch0 + c8;
        float acc[8];
        { const float4 b0 = *(const float4*)(cb + ch), b1 = *(const float4*)(cb + ch + 4); acc[0] = b0.x; acc[1] = b0.y; acc[2] = b0.z; acc[3] = b0.w; acc[4] = b1.x; acc[5] = b1.y; acc[6] = b1.z; acc[7] = b1.w; }
#pragma unroll
        for (int k = 0; k < 4; ++k) {
            if (tpos0 + l - 3 + k >= 0) {
                const uint4 raw = *(const uint4*)(proj + (tokbase + l - 3 + k) * LDP + PXBC + ch);
                float xv[8]; unpack8(raw, xv);
                const float4 w0 = *(const float4*)(cw + k * 1536 + ch), w1 = *(const float4*)(cw + k * 1536 + ch + 4);
                acc[0] += w0.x * xv[0]; acc[1] += w0.y * xv[1]; acc[2] += w0.z * xv[2]; acc[3] += w0.w * xv[3];
                acc[4] += w1.x * xv[4]; acc[5] += w1.y * xv[5]; acc[6] += w1.z * xv[6]; acc[7] += w1.w * xv[7];
            }
        }
#pragma unroll
        for (int i = 0; i < 8; ++i) acc[i] = silu_f(acc[i]) * scale;
        if (TRANS) {
#pragma unroll
            for (int i = 0; i < 8; ++i) dst[(c8 + i) * stride + l] = f2bf(acc[i]);
        } else *(uint4*)(dst + l * stride + c8) = pack8u(acc);
    }
}

__device__ __forceinline__ float head_acum(const float* __restrict__ dtbuf, size_t tokbase, int hh, float a_neg, int lane, float& d0, float& d1, float& ac0, float& ac1) {
    const int l0 = 2 * lane;
    d0 = dtbuf[(tokbase + l0) * 16 + hh]; d1 = dtbuf[(tokbase + l0 + 1) * 16 + hh];
    const float v0 = d0 * a_neg, v1 = d1 * a_neg; float s = v0 + v1;
#pragma unroll
    for (int o = 1; o < 64; o <<= 1) { const float t = __shfl_up(s, o); if (lane >= o) s += t; }
    ac0 = s - v1; ac1 = s;
    return __shfl(s, 63);
}

__device__ __forceinline__ void att_item(const Params& p, int layer, int idx, unsigned char* shm) {
    int tid0_ = threadIdx.x; asm volatile("" : "+v"(tid0_)); const int tid = tid0_, lane = tid & 63, w = __builtin_amdgcn_readfirstlane(tid >> 6), lr = lane & 15, g4 = lane >> 4;
    const int br = idx >> 11, rem = idx & 2047, bh = rem >> 6, jj = rem & 63;
    const int dsh = 2 * br, d = 1 << dsh, nbl = 64 >> dsh, r = jj >> (6 - dsh), n = jj & (nbl - 1);
    const int b = bh >> 3, h = bh & 7;
    bf16_t* Qs = (bf16_t*)shm; bf16_t* Ks = Qs + 128 * 72; bf16_t* Vt = Ks + 256 * 72;
    const bf16_t* proj = (const bf16_t*)(p.ws + OFF_PROJ);
    const float* cosT = (const float*)(p.ws + OFF_ROPE); const float* sinT = cosT + 8192 * 32;
    const float* qg = p.q_norm + layer * 64; const float* kg = p.k_norm + layer * 64;
    const int sub = tid & 7, rloc = tid >> 3;
    for (int pass = 0; pass < 6; ++pass) {
        const int row = pass * 64 + rloc; const bool isq = row < 128; const int li = isq ? row : row - 128;
        const int m = isq ? (n * 128 + li) : ((n - 1) * 128 + li); const bool valid = m >= 0;
        const int t = valid ? (m * d + r) : 0; const size_t tok = (size_t)b * SEQ + t;
        uint4 raw = make_uint4(0u, 0u, 0u, 0u);
        if (valid) raw = *(const uint4*)(proj + tok * LDP + (isq ? PAQ : PAK) + h * 64 + sub * 8);
        float v[8]; unpack8(raw, v);
        float ss = 0.f;
#pragma unroll
        for (int i = 0; i < 8; ++i) ss += v[i] * v[i];
        ss += __shfl_xor(ss, 1); ss += __shfl_xor(ss, 2); ss += __shfl_xor(ss, 4);
        const float rstd = rsqrtf(ss * (1.0f / 64.0f) + 1e-6f);
        const float* gp = (isq ? qg : kg) + sub * 8;
        const float4 g0 = *(const float4*)gp, g1 = *(const float4*)(gp + 4);
        v[0] *= rstd * g0.x; v[1] *= rstd * g0.y; v[2] *= rstd * g0.z; v[3] *= rstd * g0.w; v[4] *= rstd * g1.x; v[5] *= rstd * g1.y; v[6] *= rstd * g1.z; v[7] *= rstd * g1.w;
        const float* cp = cosT + t * 32 + (sub & 3) * 8; const float* sp = sinT + t * 32 + (sub & 3) * 8;
        const float4 c0 = *(const float4*)cp, c1 = *(const float4*)(cp + 4), s0 = *(const float4*)sp, s1 = *(const float4*)(sp + 4);
        const float cc[8] = {c0.x, c0.y, c0.z, c0.w, c1.x, c1.y, c1.z, c1.w}; const float sn[8] = {s0.x, s0.y, s0.z, s0.w, s1.x, s1.y, s1.z, s1.w};
        const float sc = isq ? 0.125f : 1.0f; float o[8];
#pragma unroll
        for (int i = 0; i < 8; ++i) { const float pv = __shfl_xor(v[i], 4); o[i] = ((sub < 4) ? (v[i] * cc[i] - pv * sn[i]) : (pv * sn[i] + v[i] * cc[i])) * sc; }
        *(uint4*)((isq ? Qs : Ks) + li * 72 + sub * 8) = pack8u(o);
    }
    for (int pass = 0; pass < 4; ++pass) {
        const int li = pass * 64 + rloc; const int m = (n - 1) * 128 + li;
        uint4 raw = make_uint4(0u, 0u, 0u, 0u);
        if (m >= 0) raw = *(const uint4*)(proj + ((size_t)b * SEQ + m * d + r) * LDP + PAV + h * 64 + sub * 8);
        bf16_t* vp = Vt + (sub * 8) * 280 + li;
        vp[0] = (bf16_t)(raw.x & 0xffffu); vp[280] = (bf16_t)(raw.x >> 16); vp[560] = (bf16_t)(raw.y & 0xffffu); vp[840] = (bf16_t)(raw.y >> 16);
        vp[1120] = (bf16_t)(raw.z & 0xffffu); vp[1400] = (bf16_t)(raw.z >> 16); vp[1680] = (bf16_t)(raw.w & 0xffffu); vp[1960] = (bf16_t)(raw.w >> 16);
    }
    for (int e = tid; e < 64 * 24; e += 512) Vt[(e / 24) * 280 + 256 + (e % 24)] = 0;
    __syncthreads();

    const int iq = 16 * w + lr;
    bf16x8 qf[2];
#pragma unroll
    for (int ks = 0; ks < 2; ++ks) qf[ks] = *(const bf16x8*)(Qs + iq * 72 + ks * 32 + g4 * 8);
    f32x4 s[9]; float mx = -INFINITY;
#pragma unroll
    for (int i = 0; i < 9; ++i) { f32x4 a = F4ZERO;
#pragma unroll
        for (int ks = 0; ks < 2; ++ks) { const bf16x8 kf = *(const bf16x8*)(Ks + ((w + i) * 16 + lr) * 72 + ks * 32 + g4 * 8); a = mfma16(kf, qf[ks], a); }
#pragma unroll
        for (int q = 0; q < 4; ++q) { const int ik = (w + i) * 16 + 4 * g4 + q; const bool ok = (ik >= iq) && (ik <= iq + 128) && (n > 0 || ik >= 128); a[q] = ok ? a[q] : -INFINITY; mx = fmaxf(mx, a[q]); }
        s[i] = a; }
    mx = fmaxf(mx, __shfl_xor(mx, 16)); mx = fmaxf(mx, __shfl_xor(mx, 32));
    float den = 0.f;
#pragma unroll
    for (int i = 0; i < 9; ++i)
#pragma unroll
        for (int q = 0; q < 4; ++q) { const float e = __expf(s[i][q] - mx); s[i][q] = e; den += e; }
    den += __shfl_xor(den, 16); den += __shfl_xor(den, 32);
    f32x4 o[4] = {F4ZERO, F4ZERO, F4ZERO, F4ZERO};
#pragma unroll
    for (int pi = 0; pi < 5; ++pi) {
        const f32x4 p0 = s[2 * pi], p1 = (2 * pi + 1 < 9) ? s[(2 * pi + 1 < 9) ? 2 * pi + 1 : 0] : F4ZERO;
        uint4 pw; pw.x = cvt_pk_bf16(p0[0], p0[1]); pw.y = cvt_pk_bf16(p0[2], p0[3]); pw.z = cvt_pk_bf16(p1[0], p1[1]); pw.w = cvt_pk_bf16(p1[2], p1[3]);
        const bf16x8 pf = as_bf8(pw);
#pragma unroll
        for (int dt = 0; dt < 4; ++dt) { const bf16_t* vp = Vt + (dt * 16 + lr) * 280 + (w + 2 * pi) * 16 + 4 * g4;
            o[dt] = mfma16(cat4(*(const bf16x4*)vp, *(const bf16x4*)(vp + 16)), pf, o[dt]); }
    }
    const float inv = 1.0f / den;
    const size_t tok = (size_t)b * SEQ + (size_t)(n * 128 + iq) * d + r;
    bf16_t* op = (bf16_t*)(p.ws + OFF_HN) + ((size_t)br * NTOK + tok) * 512 + h * 64;
#pragma unroll
    for (int dt = 0; dt < 4; ++dt) *(uint2*)(op + dt * 16 + 4 * g4) = pack4u(o[dt][0] * inv, o[dt][1] * inv, o[dt][2] * inv, o[dt][3] * inv);
    if (g4 == 0) ((float*)(p.ws + OFF_LSE))[((size_t)br * NTOK + tok) * 8 + h] = mx + __logf(den);
    __syncthreads();
}

__device__ __forceinline__ void ssd_state_item(const Params& p, int layer, int idx, unsigned char* shm) {
    int tid0_ = threadIdx.x; asm volatile("" : "+v"(tid0_)); const int tid = tid0_, lane = tid & 63, w = __builtin_amdgcn_readfirstlane(tid >> 6), lr = lane & 15, g4 = lane >> 4;
    const int g = idx & 1, bc = idx >> 1, b = bc >> 6, c = bc & 63;
    const size_t tokbase = (size_t)b * SEQ + c * 128;
    bf16_t* Bt = (bf16_t*)shm; bf16_t* Xt = Bt + 128 * 136; float* wsc = (float*)(shm + 52224);
    const bf16_t* proj = (const bf16_t*)(p.ws + OFF_PROJ);
    const float* dtbuf = (const float*)(p.ws + OFF_DT);
    const float* cw = p.conv_w + layer * 4 * 1536; const float* cb = p.conv_b + layer * 1536;
    { const int hh = 8 * g + w; float d0, d1, a0, a1;
      const float tot = head_acum(dtbuf, tokbase, hh, -__expf(p.a_log[layer * 16 + hh]), lane, d0, d1, a0, a1);
      wsc[w * 128 + 2 * lane] = __expf(tot - a0) * d0; wsc[w * 128 + 2 * lane + 1] = __expf(tot - a1) * d1;
      if (lane == 0) ((float*)(p.ws + OFF_CDEC))[bc * 16 + hh] = __expf(tot); }
    stage_conv<true>(proj, cw, cb, tokbase, c * 128, 1024 + g * 128, 128, Bt, 136, nullptr);
    for (int j = 0; j < 8; ++j) {
        const int hh = 8 * g + j;
        __syncthreads();
        stage_conv<true>(proj, cw, cb, tokbase, c * 128, hh * 64, 64, Xt, 136, wsc + j * 128);
        __syncthreads();
        f32x4 acc[4] = {F4ZERO, F4ZERO, F4ZERO, F4ZERO};
#pragma unroll
        for (int ks = 0; ks < 4; ++ks) { const bf16x8 af = *(const bf16x8*)(Bt + (w * 16 + lr) * 136 + ks * 32 + g4 * 8);
#pragma unroll
            for (int pt = 0; pt < 4; ++pt) acc[pt] = mfma16(af, *(const bf16x8*)(Xt + (pt * 16 + lr) * 136 + ks * 32 + g4 * 8), acc[pt]); }
        bf16_t* sp = (bf16_t*)(p.ws + OFF_SST) + ((size_t)bc * 16 + hh) * 8192;
#pragma unroll
        for (int pt = 0; pt < 4; ++pt) *(uint2*)(sp + (pt * 16 + lr) * 128 + w * 16 + 4 * g4) = pack4u(acc[pt][0], acc[pt][1], acc[pt][2], acc[pt][3]);
    }
    __syncthreads();
}

__device__ __forceinline__ void stage_rope64(const bf16_t* __restrict__ src  , size_t tokbase, int tpos0, const float* cosT, const float* sinT, float sc, bf16_t* dst, int rloc, int sub, int rowoff) {
    const int li = rowoff + rloc; const int t = tpos0 + li;
    const uint4 raw = *(const uint4*)(src + (tokbase + li) * LDP + sub * 8);
    float v[8]; unpack8(raw, v);
    const float* cp = cosT + t * 32 + (sub & 3) * 8; const float* sp = sinT + t * 32 + (sub & 3) * 8;
    const float4 c0 = *(const float4*)cp, c1 = *(const float4*)(cp + 4), s0 = *(const float4*)sp, s1 = *(const float4*)(sp + 4);
    const float cc[8] = {c0.x, c0.y, c0.z, c0.w, c1.x, c1.y, c1.z, c1.w}; const float sn[8] = {s0.x, s0.y, s0.z, s0.w, s1.x, s1.y, s1.z, s1.w};
    float o[8];
#pragma unroll
    for (int i = 0; i < 8; ++i) { const float pv = __shfl_xor(v[i], 4); o[i] = ((sub < 4) ? (v[i] * cc[i] - pv * sn[i]) : (pv * sn[i] + v[i] * cc[i])) * sc; }
    *(uint4*)(dst + li * 72 + sub * 8) = pack8u(o);
}
__device__ __forceinline__ void stage_vt128(const bf16_t* __restrict__ src  , size_t tokbase, bf16_t* dst) {
    const int tid = threadIdx.x, l = tid & 127, cgi = tid >> 7;
#pragma unroll
    for (int it = 0; it < 4; ++it) { const int c8 = cgi * 8 + 32 * it;
        const uint4 raw = *(const uint4*)(src + (tokbase + l) * LDP + c8);
        bf16_t* vp = dst + c8 * 136 + l;
        vp[0] = (bf16_t)(raw.x & 0xffffu); vp[136] = (bf16_t)(raw.x >> 16); vp[272] = (bf16_t)(raw.y & 0xffffu); vp[408] = (bf16_t)(raw.y >> 16);
        vp[544] = (bf16_t)(raw.z & 0xffffu); vp[680] = (bf16_t)(raw.z >> 16); vp[816] = (bf16_t)(raw.w & 0xffffu); vp[952] = (bf16_t)(raw.w >> 16); }
}

__device__ __forceinline__ void ret_state_item(const Params& p, int idx, unsigned char* shm) {
    int tid0_ = threadIdx.x; asm volatile("" : "+v"(tid0_)); const int tid = tid0_, lane = tid & 63, w = __builtin_amdgcn_readfirstlane(tid >> 6), lr = lane & 15, g4 = lane >> 4;
    const int h = idx & 3, bc = idx >> 2, b = bc >> 6, c = bc & 63;
    const size_t tokbase = (size_t)b * SEQ + c * 128;
    bf16_t* Kt = (bf16_t*)shm; bf16_t* Vt = Kt + 64 * 136;
    const bf16_t* proj = (const bf16_t*)(p.ws + OFF_PROJ);
    const float* cosT = (const float*)(p.ws + OFF_ROPE); const float* sinT = cosT + 8192 * 32;
    const float lg = log1pf(-exp2f(-5.0f - (float)h));
    { const int l = tid & 127, cgi = tid >> 7; const int t = c * 128 + l;
      const bf16_t* src = proj + (tokbase + l) * LDP + PRK + h * 64 + cgi * 8;
      float v1[8], v2[8]; unpack8(*(const uint4*)src, v1); unpack8(*(const uint4*)(src + 32), v2);
      const float* cp = cosT + t * 32 + cgi * 8; const float* sp = sinT + t * 32 + cgi * 8;
      const float4 c0 = *(const float4*)cp, c1 = *(const float4*)(cp + 4), s0 = *(const float4*)sp, s1 = *(const float4*)(sp + 4);
      const float cc[8] = {c0.x, c0.y, c0.z, c0.w, c1.x, c1.y, c1.z, c1.w}; const float sn[8] = {s0.x, s0.y, s0.z, s0.w, s1.x, s1.y, s1.z, s1.w};
      const float sc = 0.125f * __expf((float)(127 - l) * lg);
#pragma unroll
      for (int i = 0; i < 8; ++i) { Kt[(cgi * 8 + i) * 136 + l] = f2bf((v1[i] * cc[i] - v2[i] * sn[i]) * sc); Kt[(32 + cgi * 8 + i) * 136 + l] = f2bf((v1[i] * sn[i] + v2[i] * cc[i]) * sc); } }
    stage_vt128(proj + PRV + h * 128, tokbase, Vt);
    __syncthreads();
    f32x4 acc[4] = {F4ZERO, F4ZERO, F4ZERO, F4ZERO};
#pragma unroll
    for (int ks = 0; ks < 4; ++ks) { const bf16x8 bfr = *(const bf16x8*)(Vt + (w * 16 + lr) * 136 + ks * 32 + g4 * 8);
#pragma unroll
        for (int dt = 0; dt < 4; ++dt) acc[dt] = mfma16(*(const bf16x8*)(Kt + (dt * 16 + lr) * 136 + ks * 32 + g4 * 8), bfr, acc[dt]); }
    float* rp = (float*)(p.ws + OFF_RST) + ((size_t)bc * 4 + h) * 8192 + (w * 16 + lr) * 64;
#pragma unroll
    for (int dt = 0; dt < 4; ++dt) *(f32x4*)(rp + dt * 16 + 4 * g4) = acc[dt];
    __syncthreads();
}

__device__ __forceinline__ void phase_scan(const Params& p) {
    int tid0_ = threadIdx.x; asm volatile("" : "+v"(tid0_)); const int nth = gridDim.x * 512, gid = blockIdx.x * 512 + tid0_;
    const float* cdec = (const float*)(p.ws + OFF_CDEC);
    for (int it = gid; it < 131072; it += nth) {
        const int n4 = it & 31, pp = (it >> 5) & 63, hh = (it >> 11) & 15, b = it >> 15;
        float st[4] = {0.f, 0.f, 0.f, 0.f};
        bf16_t* base = (bf16_t*)(p.ws + OFF_SST) + ((size_t)(b * 64) * 16 + hh) * 8192 + pp * 128 + n4 * 4;
#pragma unroll 8
        for (int c = 0; c < 64; ++c) {
            uint2* a = (uint2*)(base + (size_t)c * 16 * 8192); const uint2 raw = *a; const float dec = cdec[(b * 64 + c) * 16 + hh];
            float v[4]; unpack4(raw, v);
            *a = pack4u(st[0], st[1], st[2], st[3]);
            st[0] = st[0] * dec + v[0]; st[1] = st[1] * dec + v[1]; st[2] = st[2] * dec + v[2]; st[3] = st[3] * dec + v[3];
        }
    }
    for (int it = gid; it < 32768; it += nth) {
        const int d4 = it & 15, e = (it >> 4) & 127, h = (it >> 11) & 3, b = it >> 13;
        const float dec = __expf(128.0f * log1pf(-exp2f(-5.0f - (float)h)));
        f32x4 st = F4ZERO;
        float* base = (float*)(p.ws + OFF_RST) + ((size_t)(b * 64) * 4 + h) * 8192 + e * 64 + d4 * 4;
#pragma unroll 8
        for (int c = 0; c < 64; ++c) { f32x4* a = (f32x4*)(base + (size_t)c * 4 * 8192); const f32x4 v = *a; *a = st; st = st * dec + v; }
    }
    const bf16_t* ao = (const bf16_t*)(p.ws + OFF_HN); const float* lse = (const float*)(p.ws + OFF_LSE); bf16_t* y = (bf16_t*)(p.ws + OFF_Y);
    for (int it = gid; it < NTOK * 64; it += nth) {
        const int sub = it & 7, h = (it >> 3) & 7, tok = it >> 6;
        const float l0 = lse[(size_t)tok * 8 + h], l1 = lse[((size_t)NTOK + tok) * 8 + h], l2 = lse[((size_t)2 * NTOK + tok) * 8 + h];
        const float m = fmaxf(l0, fmaxf(l1, l2)); float w0 = __expf(l0 - m), w1 = __expf(l1 - m), w2 = __expf(l2 - m); const float inv = 1.0f / (w0 + w1 + w2); w0 *= inv; w1 *= inv; w2 *= inv;
        float a0[8], a1[8], a2[8], o[8];
        unpack8(*(const uint4*)(ao + (size_t)tok * 512 + h * 64 + sub * 8), a0);
        unpack8(*(const uint4*)(ao + ((size_t)NTOK + tok) * 512 + h * 64 + sub * 8), a1);
        unpack8(*(const uint4*)(ao + ((size_t)2 * NTOK + tok) * 512 + h * 64 + sub * 8), a2);
#pragma unroll
        for (int i = 0; i < 8; ++i) o[i] = w0 * a0[i] + w1 * a1[i] + w2 * a2[i];
        *(uint4*)(y + (size_t)tok * DM + 1024 + h * 64 + sub * 8) = pack8u(o);
    }
}

__device__ __forceinline__ void ssd_out_item(const Params& p, int layer, int idx, unsigned char* shm) {
    int tid0_ = threadIdx.x; asm volatile("" : "+v"(tid0_)); const int tid = tid0_, lane = tid & 63, w = __builtin_amdgcn_readfirstlane(tid >> 6), lr = lane & 15, g4 = lane >> 4;
    const int g = idx & 1, bc = idx >> 1, b = bc >> 6, c = bc & 63;
    const size_t tokbase = (size_t)b * SEQ + c * 128;
    bf16_t* Cs = (bf16_t*)shm; bf16_t* Bs = Cs + 128 * 136; bf16_t* Xt = Bs + 128 * 136; bf16_t* Pv = Xt + 64 * 136;
    float* dts = (float*)(shm + 104448); float* acs = dts + 8 * 128;
    const bf16_t* proj = (const bf16_t*)(p.ws + OFF_PROJ);
    const float* dtbuf = (const float*)(p.ws + OFF_DT);
    const float* cw = p.conv_w + layer * 4 * 1536; const float* cb = p.conv_b + layer * 1536;
    bf16_t* y = (bf16_t*)(p.ws + OFF_Y);
    { const int hh = 8 * g + w; float d0, d1, a0, a1;
      (void)head_acum(dtbuf, tokbase, hh, -__expf(p.a_log[layer * 16 + hh]), lane, d0, d1, a0, a1);
      dts[w * 128 + 2 * lane] = d0; dts[w * 128 + 2 * lane + 1] = d1; acs[w * 128 + 2 * lane] = a0; acs[w * 128 + 2 * lane + 1] = a1; }
    stage_conv<false>(proj, cw, cb, tokbase, c * 128, 1280 + g * 128, 128, Cs, 136, nullptr);
    stage_conv<false>(proj, cw, cb, tokbase, c * 128, 1024 + g * 128, 128, Bs, 136, nullptr);
    __syncthreads();
    const int l = w * 16 + lr;
    bf16x8 cf[4];
#pragma unroll
    for (int ks = 0; ks < 4; ++ks) cf[ks] = *(const bf16x8*)(Cs + l * 136 + ks * 32 + g4 * 8);
    f32x4 cbt[8];
#pragma unroll
    for (int st = 0; st < 8; ++st) { cbt[st] = F4ZERO;
        if (st <= w) {
#pragma unroll
            for (int ks = 0; ks < 4; ++ks) cbt[st] = mfma16(*(const bf16x8*)(Bs + (st * 16 + lr) * 136 + ks * 32 + g4 * 8), cf[ks], cbt[st]); } }
    float ssq = 0.f;
    const size_t tok = tokbase + l;
#pragma unroll 1
    for (int j = 0; j < 8; ++j) {
        const int hh = 8 * g + j;
        __syncthreads();
        stage_conv<true>(proj, cw, cb, tokbase, c * 128, hh * 64, 64, Xt, 136, nullptr);
        { const bf16_t* src = (const bf16_t*)(p.ws + OFF_SST) + ((size_t)bc * 16 + hh) * 8192;
#pragma unroll
          for (int it = 0; it < 2; ++it) { const int e = tid * 8 + it * 4096; *(uint4*)(Pv + (e >> 7) * 136 + (e & 127)) = *(const uint4*)(src + e); } }
        __syncthreads();
        const float* dth = dts + j * 128; const float* ach = acs + j * 128;
        const float al = ach[l], dsk = p.d_skip[layer * 16 + hh];
        f32x4 acc[4] = {F4ZERO, F4ZERO, F4ZERO, F4ZERO};
#pragma unroll
        for (int sp = 0; sp < 4; ++sp) {
            if (2 * sp <= w) {
                float m[8];
#pragma unroll
                for (int half = 0; half < 2; ++half) { const int T = 2 * sp + half;
                    const float4 av = *(const float4*)(ach + T * 16 + 4 * g4), dv = *(const float4*)(dth + T * 16 + 4 * g4);
                    const float aa[4] = {av.x, av.y, av.z, av.w}, dd[4] = {dv.x, dv.y, dv.z, dv.w};
#pragma unroll
                    for (int q = 0; q < 4; ++q) { const int s = T * 16 + 4 * g4 + q; float mv = (s <= l) ? cbt[T][q] * __expf(al - aa[q]) * dd[q] : 0.f; if (s == l) mv += dsk; m[half * 4 + q] = mv; } }
                const bf16x8 pf = as_bf8(pack8u(m));
#pragma unroll
                for (int pt = 0; pt < 4; ++pt) { const bf16_t* vp = Xt + (pt * 16 + lr) * 136 + (2 * sp) * 16 + 4 * g4;
                    acc[pt] = mfma16(cat4(*(const bf16x4*)vp, *(const bf16x4*)(vp + 16)), pf, acc[pt]); }
            }
        }
        f32x4 off[4] = {F4ZERO, F4ZERO, F4ZERO, F4ZERO};
#pragma unroll
        for (int ks = 0; ks < 4; ++ks)
#pragma unroll
            for (int pt = 0; pt < 4; ++pt) off[pt] = mfma16(*(const bf16x8*)(Pv + (pt * 16 + lr) * 136 + ks * 32 + g4 * 8), cf[ks], off[pt]);
        const float ea = __expf(al);
#pragma unroll
        for (int pt = 0; pt < 4; ++pt) { const int col = hh * 64 + pt * 16 + 4 * g4;
            float z[4]; unpack4(*(const uint2*)(proj + tok * LDP + col), z);
            float yv[4];
#pragma unroll
            for (int q = 0; q < 4; ++q) { yv[q] = (acc[pt][q] + off[pt][q] * ea) * silu_f(z[q]); ssq += yv[q] * yv[q]; }
            *(uint2*)(y + tok * DM + col) = pack4u(yv[0], yv[1], yv[2], yv[3]); }
    }
    ssq += __shfl_xor(ssq, 16); ssq += __shfl_xor(ssq, 32);
    const float scale = rsqrtf(ssq * (1.0f / 512.0f) + 1e-6f);
    const float* nw = p.ssd_norm + layer * 1024;
#pragma unroll 1
    for (int j = 0; j < 8; ++j)
#pragma unroll
        for (int pt = 0; pt < 4; ++pt) { const int col = (8 * g + j) * 64 + pt * 16 + 4 * g4;
            float yv[4]; unpack4(*(const uint2*)(y + tok * DM + col), yv); const float4 nv = *(const float4*)(nw + col);
            *(uint2*)(y + tok * DM + col) = pack4u(yv[0] * scale * nv.x, yv[1] * scale * nv.y, yv[2] * scale * nv.z, yv[3] * scale * nv.w); }
    __syncthreads();
}

__device__ __forceinline__ void ret_out_item(const Params& p, int layer, int idx, unsigned char* shm) {
    int tid0_ = threadIdx.x; asm volatile("" : "+v"(tid0_)); const int tid = tid0_, lane = tid & 63, w = __builtin_amdgcn_readfirstlane(tid >> 6), lr = lane & 15, g4 = lane >> 4;
    const int h = idx & 3, bc = idx >> 2, b = bc >> 6, c = bc & 63;
    const size_t tokbase = (size_t)b * SEQ + c * 128;
    bf16_t* Qs = (bf16_t*)shm; bf16_t* Ks = Qs + 128 * 72; bf16_t* Vt = Ks + 128 * 72; bf16_t* Pt = Vt + 128 * 136;
    const bf16_t* proj = (const bf16_t*)(p.ws + OFF_PROJ);
    const float* cosT = (const float*)(p.ws + OFF_ROPE); const float* sinT = cosT + 8192 * 32;
    const float lg = log1pf(-exp2f(-5.0f - (float)h)), lg2 = lg * 1.4426950408889634f;
    { const int sub = tid & 7, rloc = tid >> 3;
      stage_rope64(proj + PRQ + h * 64, tokbase, c * 128, cosT, sinT, 1.0f, Qs, rloc, sub, 0);
      stage_rope64(proj + PRQ + h * 64, tokbase, c * 128, cosT, sinT, 1.0f, Qs, rloc, sub, 64);
      stage_rope64(proj + PRK + h * 64, tokbase, c * 128, cosT, sinT, 0.125f, Ks, rloc, sub, 0);
      stage_rope64(proj + PRK + h * 64, tokbase, c * 128, cosT, sinT, 0.125f, Ks, rloc, sub, 64); }
    stage_vt128(proj + PRV + h * 128, tokbase, Vt);
    { const float* src = (const float*)(p.ws + OFF_RST) + ((size_t)bc * 4 + h) * 8192 + (tid >> 2) * 64 + (tid & 3) * 16;
      float v[16];
#pragma unroll
      for (int q = 0; q < 4; ++q) { const float4 f = *(const float4*)(src + 4 * q); v[4 * q] = f.x; v[4 * q + 1] = f.y; v[4 * q + 2] = f.z; v[4 * q + 3] = f.w; }
      bf16_t* dp = Pt + (tid >> 2) * 72 + (tid & 3) * 16;
      *(uint4*)dp = pack8u(v); *(uint4*)(dp + 8) = pack8u(v + 8); }
    __syncthreads();
    const int l = w * 16 + lr;
    bf16x8 qf[2];
#pragma unroll
    for (int ks = 0; ks < 2; ++ks) qf[ks] = *(const bf16x8*)(Qs + l * 72 + ks * 32 + g4 * 8);
    f32x4 o[8], cr[8];
#pragma unroll
    for (int et = 0; et < 8; ++et) { o[et] = F4ZERO; cr[et] = F4ZERO; }
#pragma unroll
    for (int sp = 0; sp < 4; ++sp) {
        if (2 * sp <= w) {
            float m[8];
#pragma unroll
            for (int half = 0; half < 2; ++half) { const int T = 2 * sp + half; f32x4 sc = F4ZERO;
                if (T <= w) {
#pragma unroll
                    for (int ks = 0; ks < 2; ++ks) sc = mfma16(*(const bf16x8*)(Ks + (T * 16 + lr) * 72 + ks * 32 + g4 * 8), qf[ks], sc); }
#pragma unroll
                for (int q = 0; q < 4; ++q) { const int s = T * 16 + 4 * g4 + q; m[half * 4 + q] = (s <= l) ? sc[q] * exp2f((float)(l - s) * lg2) : 0.f; } }
            const bf16x8 pf = as_bf8(pack8u(m));
#pragma unroll
            for (int et = 0; et < 8; ++et) { const bf16_t* vp = Vt + (et * 16 + lr) * 136 + (2 * sp) * 16 + 4 * g4;
                o[et] = mfma16(cat4(*(const bf16x4*)vp, *(const bf16x4*)(vp + 16)), pf, o[et]); }
        }
    }
#pragma unroll
    for (int ks = 0; ks < 2; ++ks)
#pragma unroll
        for (int et = 0; et < 8; ++et) cr[et] = mfma16(*(const bf16x8*)(Pt + (et * 16 + lr) * 72 + ks * 32 + g4 * 8), qf[ks], cr[et]);
    const float gl = exp2f((float)(l + 1) * lg2);
    float ssq = 0.f;
#pragma unroll
    for (int et = 0; et < 8; ++et)
#pragma unroll
        for (int q = 0; q < 4; ++q) { o[et][q] += cr[et][q] * gl; ssq += o[et][q] * o[et][q]; }
    ssq += __shfl_xor(ssq, 16); ssq += __shfl_xor(ssq, 32);
    const float scale = rsqrtf(ssq * (1.0f / 128.0f) + 1e-6f);
    const size_t tok = tokbase + l;
    const float* nw = p.ret_norm + layer * 512;
    bf16_t* y = (bf16_t*)(p.ws + OFF_Y);
#pragma unroll
    for (int et = 0; et < 8; ++et) { const int col = h * 128 + et * 16 + 4 * g4;
        float gt[4]; unpack4(*(const uint2*)(proj + tok * LDP + PRG + col), gt); const float4 nv = *(const float4*)(nw + col);
        *(uint2*)(y + tok * DM + 1536 + col) = pack4u(o[et][0] * scale * nv.x * silu_f(gt[0]), o[et][1] * scale * nv.y * silu_f(gt[1]), o[et][2] * scale * nv.z * silu_f(gt[2]), o[et][3] * scale * nv.w * silu_f(gt[3])); }
    __syncthreads();
}

__global__ __launch_bounds__(512, 2) void hybrid_fwd(Params p) {
    extern __shared__ __attribute__((aligned(16))) unsigned char shm[];
    cg::grid_group grid = cg::this_grid();
    bf16_t* hn = (bf16_t*)(p.ws + OFF_HN); bf16_t* ybuf = (bf16_t*)(p.ws + OFF_Y); bf16_t* proj = (bf16_t*)(p.ws + OFF_PROJ);
    phase_prep(p, shm);
#pragma unroll 1
    for (int layer = 0; layer < 2; ++layer) {
        const float* xin = layer == 0 ? p.x : p.out;
        phase_norm<true>(xin, p.ln_mix + layer * DM, hn, p.w_in + (size_t)layer * DM * INW, p.dt_bias + layer * 16, (float*)(p.ws + OFF_DT), shm);
        grid.sync();
        { pg8::EpiProj E; E.O = proj; E.ldc = LDP; run_gemm(shm, hn, (const bf16_t*)(p.ws + OFF_WIN + layer * SZ_WIN), NTOK, 5632, DM, E); }
        grid.sync();
        for (int it = blockIdx.x; it < 7680; it += gridDim.x) {
            if (it < 6144) att_item(p, layer, it, shm);
            else if (it < 6656) ssd_state_item(p, layer, it - 6144, shm);
            else ret_state_item(p, it - 6656, shm);
        }
        grid.sync();
        phase_scan(p);
        grid.sync();
        for (int it = blockIdx.x; it < 1536; it += gridDim.x) {
            if (it < 512) ssd_out_item(p, layer, it, shm);
            else ret_out_item(p, layer, it - 512, shm);
        }
        grid.sync();
        { pg8::EpiRes E; E.C = p.out; E.R = xin; E.ldc = DM; run_gemm(shm, ybuf, (const bf16_t*)(p.ws + OFF_WOUT + layer * SZ_WOUT), NTOK, DM, DM, E); }
        grid.sync();
        phase_norm<false>(p.out, p.ln_ffn + layer * DM, hn, nullptr, nullptr, nullptr, shm);
        grid.sync();
        { pg8::EpiSwiGLU E; E.H = proj; E.ldc = DFF; run_gemm(shm, hn, (const bf16_t*)(p.ws + OFF_WGU + layer * SZ_WGU), NTOK, 2 * DFF, DM, E); }
        grid.sync();
        { pg8::EpiRes E; E.C = p.out; E.R = p.out; E.ldc = DM; run_gemm(shm, proj, (const bf16_t*)(p.ws + OFF_WDN + layer * SZ_WDN), NTOK, DM, DFF, E); }
        grid.sync();
    }
}

extern "C" void kernel_launch(void* const* d_in, const int* in_sizes, int n_in, void* d_out, int out_size, void* d_ws, size_t ws_size, hipStream_t stream) {
    static int grid = 0;
    if (grid == 0) {
        if (n_in != 17 || ws_size < WS_END) { fprintf(stderr, "kernel_launch: unexpected n_in %d / ws_size %zu (need %zu)\n", n_in, ws_size, (size_t)WS_END); grid = -1; return; }
        int dev = 0, cus = 0, per_cu = 0;
        (void)hipGetDevice(&dev); (void)hipDeviceGetAttribute(&cus, hipDeviceAttributeMultiprocessorCount, dev);
        if (hipFuncSetAttribute((const void*)hybrid_fwd, hipFuncAttributeMaxDynamicSharedMemorySize, LDS_BYTES) != hipSuccess) { fprintf(stderr, "kernel_launch: hipFuncSetAttribute failed\n"); grid = -1; return; }
        if (hipOccupancyMaxActiveBlocksPerMultiprocessor(&per_cu, (const void*)hybrid_fwd, 512, LDS_BYTES) != hipSuccess || per_cu < 1) { fprintf(stderr, "kernel_launch: occupancy query says %d\n", per_cu); per_cu = 1; }
        (void)hipGetLastError();
        grid = cus * per_cu;
    }
    if (grid < 0) return;
    Params p{};
    const float** f = (const float**)&p;
    for (int i = 0; i < 17; ++i) f[i] = (const float*)d_in[i];
    p.out = (float*)d_out; p.ws = (unsigned char*)d_ws;
    void* args[] = {&p};
    const hipError_t e = hipLaunchCooperativeKernel((const void*)hybrid_fwd, dim3(grid), dim3(512), args, LDS_BYTES, stream);
    if (e != hipSuccess) fprintf(stderr, "kernel_launch: cooperative launch failed: %s (grid %d)\n", hipGetErrorString(e), grid);
}
```

```cpp
#include <hip/hip_runtime.h>
#include <hip/hip_cooperative_groups.h>
#include <cstdio>
namespace cg = cooperative_groups;
#ifndef PROBE_MASK
#define PROBE_MASK 0
#endif
#ifndef PROBE_K
#define PROBE_K 2
#endif
#ifndef PROBE_GEMM
#define PROBE_GEMM 9
#endif
#ifndef REP_SO
#define REP_SO 1
#endif
#ifndef REP_RO
#define REP_RO 1
#endif
#ifndef SSD_OUT
#define SSD_OUT ssd_out_item2
#endif
#include <cstdint>
#define XB_TMO      128
#define XB_XCNT(j)  (256  + 64 * (j))
#define XB_XSUB(j)  (1280 + 64 * (j))
#define XB_XGEN(j)  (2304 + 64 * (j))
#define XB_TOP      3328
#define XB_TOPGEN   3392
#define XCD_BAR_WORDS 3456
#define XB_SPIN_CAP (1u << 18)
#define XLAS __attribute__((address_space(3)))

__device__ __forceinline__ unsigned xb_ld(unsigned* p)              { return __hip_atomic_load(p, __ATOMIC_RELAXED, __HIP_MEMORY_SCOPE_AGENT); }
__device__ __forceinline__ unsigned xb_add(unsigned* p, unsigned v) { return __hip_atomic_fetch_add(p, v, __ATOMIC_RELAXED, __HIP_MEMORY_SCOPE_AGENT); }
__device__ __forceinline__ unsigned xb_xcc_id() { return (unsigned)__builtin_amdgcn_s_getreg((3 << 11) | 20) & 0xFu; }
#define XB_SPIN(cond, bar) do { unsigned _sp = 0; while (cond) { __builtin_amdgcn_s_sleep(1); \
    if ((++_sp & 255u) == 0u) { if (xb_ld(&(bar)[XB_TMO])) break; if (_sp > XB_SPIN_CAP) { atomicAdd(&(bar)[XB_TMO], 1u); break; } } } } while (0)

struct XcdBarrier {
    unsigned* bar; unsigned x;
    volatile XLAS unsigned* st;
};

__device__ __forceinline__ XcdBarrier xcd_barrier_post(unsigned* bar, volatile XLAS unsigned* st) {
    XcdBarrier b; b.bar = bar; b.x = xb_xcc_id(); b.st = st;
    if (threadIdx.x == 0) (void)xb_add(&bar[XB_XCNT(b.x)], 1u);
    return b;
}
__device__ __forceinline__ void xcd_barrier_complete(unsigned* bar, unsigned x, unsigned& nloc, unsigned& nx) {
    const unsigned G = gridDim.x * gridDim.y * gridDim.z;
    unsigned sum, cnt, mine, sp = 0u;
    for (;;) {
        sum = 0u; cnt = 0u; mine = 0u;
#pragma unroll
        for (unsigned j = 0; j < 16; ++j) { const unsigned c = xb_ld(&bar[XB_XCNT(j)]); sum += c; cnt += (c > 0u) ? 1u : 0u; mine = (j == x) ? c : mine; }
        if (sum == G) break;
        __builtin_amdgcn_s_sleep(1);
        if ((++sp & 255u) == 0u) { if (xb_ld(&bar[XB_TMO])) break; if (sp > XB_SPIN_CAP) { atomicAdd(&bar[XB_TMO], 1u); break; } }
    }
    nloc = mine > 0u ? mine : 1u; nx = cnt > 0u ? cnt : 1u;
}

__device__ __forceinline__ void xcd_barrier(const XcdBarrier& b) {
    asm volatile("s_waitcnt vmcnt(0)" ::: "memory");
    __syncthreads();
    if (threadIdx.x == 0) {
        unsigned* bar = b.bar;
        __builtin_amdgcn_s_waitcnt(0);
        unsigned nloc = b.st[0], nx = b.st[1];
        if (nloc == 0u) { xcd_barrier_complete(bar, b.x, nloc, nx); b.st[0] = nloc; b.st[1] = nx; }
        const unsigned old = xb_add(&bar[XB_XSUB(b.x)], 1u);
        const unsigned gen = old / nloc;
        if (old + 1u == (gen + 1u) * nloc) {
            __builtin_amdgcn_fence(__ATOMIC_RELEASE, "agent");
            asm volatile("s_waitcnt vmcnt(0)" ::: "memory");
            const unsigned og = xb_add(&bar[XB_TOP], 1u);
            const unsigned tg = og / nx;
            if (og + 1u == (tg + 1u) * nx) xb_add(&bar[XB_TOPGEN], 1u);
            else XB_SPIN(xb_ld(&bar[XB_TOPGEN]) == tg, bar);
            __builtin_amdgcn_fence(__ATOMIC_ACQUIRE, "agent");
            xb_add(&bar[XB_XGEN(b.x)], 1u);
            asm volatile("s_waitcnt vmcnt(0)" ::: "memory");
        } else {
            XB_SPIN(xb_ld(&bar[XB_XGEN(b.x)]) == gen, bar);
            __builtin_amdgcn_fence(__ATOMIC_ACQUIRE, "agent");
            asm volatile("s_waitcnt vmcnt(0)" ::: "memory");
        }
    }
    __syncthreads();
}

namespace pg8 {
#define PG8_LAS __attribute__((address_space(3)))
typedef unsigned short bf16_t;
typedef short bf16x8 __attribute__((ext_vector_type(8)));
typedef float f32x4 __attribute__((ext_vector_type(4)));
typedef unsigned u32x4 __attribute__((ext_vector_type(4)));
constexpr int BM = 256, BK = 64, HALF = 128, HTB = HALF * BK * 2  , STAGE_BYTES = 8 * HTB, NXCD = 8, WGM = 8;

__host__ __device__ __forceinline__ int lds_byte(int r, int c) { const int st = (r >> 4) * 2 + (c >> 5), rr = r & 15, cc = c & 31, ob = rr * 64 + cc * 2; return st * 1024 + (ob ^ (((ob >> 9) & 1) << 5)); }
__host__ __device__ __forceinline__ void stage_rc(int b, int& R, int& C) { const int st = b / 1024, sb = b % 1024, swz = sb ^ (((sb >> 9) & 1) << 5); R = (st >> 1) * 16 + swz / 64; C = (st & 1) * 32 + (swz % 64) / 2; }
__host__ __device__ __forceinline__ int perm32(int rho) { const int n = rho >> 4, i = rho & 15; return 8 * (i >> 2) + 4 * n + (i & 3); }

struct Unit { int pm, pn; };
struct Gemm { const bf16_t* A; const bf16_t* Bt; int M, N, K; };

struct StaticOrder {
    int nM, nN, nwg, G, c;
    __host__ __device__ void init(int M, int N, int G_, int c_) { nM = M / BM; nN = N / BM; nwg = nM * nN; G = G_; c = c_; }
    __host__ __device__ bool next(int i, Unit& u) const {
        const long L = (long)i * G + c; if (L >= nwg) return false;
        int wgid = (int)L; { const int q = nwg / NXCD, r = nwg % NXCD, xcd = wgid % NXCD, off = wgid / NXCD; wgid = (xcd < r ? xcd * (q + 1) : r * (q + 1) + (xcd - r) * q) + off; }
        const int nig = WGM * nN, gid = wgid / nig, fm = gid * WGM, gsz = (nM - fm) < WGM ? (nM - fm) : WGM;
        u.pm = fm + ((wgid % nig) % gsz); u.pn = (wgid % nig) / gsz; return true;
    }
    __device__ __forceinline__ void a_ready(const Unit&) const {}
    __device__ __forceinline__ void done(const Unit&) const {}
};
__device__ __forceinline__ unsigned cvt_pk_bf16(float lo, float hi) { unsigned r; asm volatile("v_cvt_pk_bf16_f32 %0, %1, %2" : "=v"(r) : "v"(lo), "v"(hi)); return r; }
struct EpiProj {
    static constexpr bool PERM = true, AFTER_DRAIN = false;
    bf16_t* O; int ldc; const float* rs;
    __device__ __forceinline__ void operator()(const f32x4 (&acc)[2][2][4][2], const Unit& u, int wr, int wc, int fr, int fq) const {
        const int row0 = u.pm * BM + wr * 64 + fr, col0 = u.pn * BM + wc * 32 + 8 * fq;
#pragma unroll
        for (int ai = 0; ai < 2; ++ai)
#pragma unroll
            for (int m = 0; m < 4; ++m) { bf16_t* rowp = O + (size_t)(row0 + ai * HALF + m * 16) * ldc + col0; const float sc = rs ? rs[row0 + ai * HALF + m * 16] : 1.0f;
#pragma unroll
                for (int bj = 0; bj < 2; ++bj) { const f32x4 v0 = acc[ai][bj][m][0] * sc, v1 = acc[ai][bj][m][1] * sc;
                    u32x4 w; w.x = cvt_pk_bf16(v0[0], v0[1]); w.y = cvt_pk_bf16(v0[2], v0[3]); w.z = cvt_pk_bf16(v1[0], v1[1]); w.w = cvt_pk_bf16(v1[2], v1[3]);
                    *(u32x4*)(rowp + bj * HALF) = w; } }
    }
};
struct EpiRes {
    static constexpr bool PERM = false, AFTER_DRAIN = false;
    float* C; const bf16_t* R; int ldc;
    __device__ __forceinline__ void operator()(const f32x4 (&acc)[2][2][4][2], const Unit& u, int wr, int wc, int fr, int fq) const {
        const int row0 = u.pm * BM + wr * 64 + fr, col0 = u.pn * BM + wc * 32 + 4 * fq;
#pragma unroll
        for (int ai = 0; ai < 2; ++ai)
#pragma unroll
            for (int m = 0; m < 4; ++m) { const size_t ro = (size_t)(row0 + ai * HALF + m * 16) * ldc + col0;
#pragma unroll
                for (int bj = 0; bj < 2; ++bj)
#pragma unroll
                    for (int n = 0; n < 2; ++n) { const uint2 rw = *(const uint2*)(R + ro + bj * HALF + n * 16);
                        f32x4 r; r[0] = __uint_as_float(rw.x << 16); r[1] = __uint_as_float(rw.x & 0xffff0000u); r[2] = __uint_as_float(rw.y << 16); r[3] = __uint_as_float(rw.y & 0xffff0000u);
                        *(f32x4*)(C + ro + bj * HALF + n * 16) = acc[ai][bj][m][n] + r; } }
    }
};
__device__ __forceinline__ float silu_f(float v) { return v * __builtin_amdgcn_rcpf(1.0f + __expf(-v)); }
struct EpiSwiGLU {
    static constexpr bool PERM = true, AFTER_DRAIN = false;
    bf16_t* H; int ldc; const float* rs;
    __device__ __forceinline__ void operator()(const f32x4 (&acc)[2][2][4][2], const Unit& u, int wr, int wc, int fr, int fq) const {
        const int row0 = u.pm * BM + wr * 64 + fr, col0 = u.pn * HALF + wc * 32 + 8 * fq;
#pragma unroll
        for (int ai = 0; ai < 2; ++ai)
#pragma unroll
            for (int m = 0; m < 4; ++m) { bf16_t* rowp = H + (size_t)(row0 + ai * HALF + m * 16) * ldc + col0; const float sc = rs ? rs[row0 + ai * HALF + m * 16] : 1.0f;
                f32x4 v0, v1;
#pragma unroll
                for (int j = 0; j < 4; ++j) { v0[j] = silu_f(acc[ai][0][m][0][j] * sc) * (acc[ai][1][m][0][j] * sc); v1[j] = silu_f(acc[ai][0][m][1][j] * sc) * (acc[ai][1][m][1][j] * sc); }
                u32x4 w; w.x = cvt_pk_bf16(v0[0], v0[1]); w.y = cvt_pk_bf16(v0[2], v0[3]); w.z = cvt_pk_bf16(v1[0], v1[1]); w.w = cvt_pk_bf16(v1[2], v1[3]);
                *(u32x4*)rowp = w; }
    }
};
struct EpiAccB {
    static constexpr bool PERM = true, AFTER_DRAIN = false;
    bf16_t* X; int ldc;
    __device__ __forceinline__ void operator()(const f32x4 (&acc)[2][2][4][2], const Unit& u, int wr, int wc, int fr, int fq) const {
        const int row0 = u.pm * BM + wr * 64 + fr, col0 = u.pn * BM + wc * 32 + 8 * fq;
#pragma unroll
        for (int ai = 0; ai < 2; ++ai) {
            u32x4 old[4][2];
#pragma unroll
            for (int m = 0; m < 4; ++m)
#pragma unroll
                for (int bj = 0; bj < 2; ++bj) old[m][bj] = *(const u32x4*)(X + (size_t)(row0 + ai * HALF + m * 16) * ldc + col0 + bj * HALF);
#pragma unroll
            for (int m = 0; m < 4; ++m)
#pragma unroll
                for (int bj = 0; bj < 2; ++bj) { const f32x4 v0 = acc[ai][bj][m][0], v1 = acc[ai][bj][m][1]; const u32x4 o = old[m][bj];
                    u32x4 w;
                    w.x = cvt_pk_bf16(v0[0] + __uint_as_float(o.x << 16), v0[1] + __uint_as_float(o.x & 0xffff0000u)); w.y = cvt_pk_bf16(v0[2] + __uint_as_float(o.y << 16), v0[3] + __uint_as_float(o.y & 0xffff0000u));
                    w.z = cvt_pk_bf16(v1[0] + __uint_as_float(o.z << 16), v1[1] + __uint_as_float(o.z & 0xffff0000u)); w.w = cvt_pk_bf16(v1[2] + __uint_as_float(o.w << 16), v1[3] + __uint_as_float(o.w & 0xffff0000u));
                    *(u32x4*)(X + (size_t)(row0 + ai * HALF + m * 16) * ldc + col0 + bj * HALF) = w; }
        }
    }
};
template <class Epi, class Sched, bool ALIGN_EPI = false, bool SP2 = false>
__device__ __forceinline__ void gemm_phase(PG8_LAS unsigned char* lds, const Gemm g, const Sched& S, const Epi& E) {
    int tid0_ = threadIdx.x; asm volatile("" : "+v"(tid0_)); const int tid = tid0_, wid = __builtin_amdgcn_readfirstlane(tid >> 6), lane = tid & 63, wr = wid >> 2, wc = wid & 3, fr = lane & 15, fq = lane >> 4;
    const int K = g.K, nt = K / BK;
    unsigned voffA[2], voffB[2];
#pragma unroll
    for (int i = 0; i < 2; ++i) { int R, C; stage_rc(tid * 16 + i * 8192, R, C); const int Rb = Epi::PERM ? ((R & ~31) + perm32(R & 31)) : R;
        voffA[i] = (unsigned)(R * K + C) * 2u; voffB[i] = (unsigned)(Rb * K + C) * 2u; }
    const size_t kstep = (size_t)(BK * 2);
    const size_t hstep = (size_t)HALF * K * 2;
    const size_t tstep = 2 * hstep;
    const unsigned ldsw = (unsigned)wid * 1024u;
    const int aoff = lds_byte(wr * 64 + fr, fq * 8), boff = lds_byte(wc * 32 + fr, fq * 8);
#define PG8_SA(b, h) (((b) * 2 + (h)) * HTB)
#define PG8_SB(b, h) ((4 + (b) * 2 + (h)) * HTB)
#define PG8_STAGE(bufoff, gbase, voff) do { _Pragma("unroll") for (int _i = 0; _i < 2; ++_i) \
        __builtin_amdgcn_global_load_lds((const unsigned*)((const char*)(gbase) + (voff)[_i]), (PG8_LAS unsigned*)(lds + (bufoff) + ldsw + _i * 8192), 16, 0, 0); } while (0)
#define PG8_LDA(dst, b, h) do { _Pragma("unroll") for (int m = 0; m < 4; ++m) _Pragma("unroll") for (int k = 0; k < 2; ++k) dst[m][k] = *(const PG8_LAS bf16x8*)(lds + PG8_SA(b, h) + aoff + m * 2048 + k * 1024); } while (0)
#define PG8_LDB(dst, b, h) do { _Pragma("unroll") for (int n = 0; n < 2; ++n) _Pragma("unroll") for (int k = 0; k < 2; ++k) dst[n][k] = *(const PG8_LAS bf16x8*)(lds + PG8_SB(b, h) + boff + n * 2048 + k * 1024); } while (0)
#define PG8_MMA(ai, bj, At, Bt) do { __builtin_amdgcn_s_setprio(1); _Pragma("unroll") for (int m = 0; m < 4; ++m) _Pragma("unroll") for (int n = 0; n < 2; ++n) _Pragma("unroll") for (int k = 0; k < 2; ++k) \
        acc[ai][bj][m][n] = __builtin_amdgcn_mfma_f32_16x16x32_bf16(Bt[n][k], At[m][k], acc[ai][bj][m][n], 0, 0, 0); __builtin_amdgcn_s_setprio(0); } while (0)
#define PG8_WAIT_V(n) asm volatile("s_waitcnt vmcnt(" #n ")" ::: "memory")
#define PG8_WAIT_L(n) asm volatile("s_waitcnt lgkmcnt(" #n ")" ::: "memory")
#define PG8_BAR __builtin_amdgcn_s_barrier()
#define PG8_SCHED __builtin_amdgcn_sched_barrier(0)
    Unit cur, nxt; int ui = 0;
    if (!S.next(0, cur)) return;
    f32x4 acc[2][2][4][2];
#pragma unroll
    for (int a = 0; a < 2; ++a)
#pragma unroll
        for (int b = 0; b < 2; ++b)
#pragma unroll
            for (int m = 0; m < 4; ++m)
#pragma unroll
                for (int n = 0; n < 2; ++n) acc[a][b][m][n] = (f32x4){0.f, 0.f, 0.f, 0.f};
    bf16x8 At[4][2], B0[2][2], B1[2][2];
    const char* cA = (const char*)g.A + (size_t)cur.pm * tstep; const char* cB = (const char*)g.Bt + (size_t)cur.pn * tstep;
    S.a_ready(cur);
    if constexpr (SP2) {
        PG8_STAGE(PG8_SB(0, 0), cB, voffB); PG8_STAGE(PG8_SB(0, 1), cB + hstep, voffB); PG8_STAGE(PG8_SA(0, 0), cA, voffA); PG8_STAGE(PG8_SA(0, 1), cA + hstep, voffA);
        if (wr == 1) PG8_BAR;
        PG8_WAIT_V(2); PG8_BAR;
        PG8_STAGE(PG8_SB(1, 0), cB + kstep, voffB); PG8_STAGE(PG8_SA(1, 0), cA + kstep, voffA); PG8_STAGE(PG8_SB(1, 1), cB + hstep + kstep, voffB);
        PG8_WAIT_V(6); PG8_BAR;
    } else {
        PG8_STAGE(PG8_SB(0, 0), cB, voffB); PG8_STAGE(PG8_SA(0, 0), cA, voffA); PG8_STAGE(PG8_SB(0, 1), cB + hstep, voffB); PG8_STAGE(PG8_SA(0, 1), cA + hstep, voffA);
        if (wr == 1) PG8_BAR;
        PG8_WAIT_V(4); PG8_BAR;
        PG8_STAGE(PG8_SB(1, 0), cB + kstep, voffB); PG8_STAGE(PG8_SA(1, 0), cA + kstep, voffA); PG8_STAGE(PG8_SB(1, 1), cB + hstep + kstep, voffB);
        PG8_WAIT_V(6); PG8_BAR;
    }
    for (;;) {
        const bool has_next = S.next(ui + 1, nxt);
        const char* nA = has_next ? (const char*)g.A + (size_t)nxt.pm * tstep : cA; const char* nB = has_next ? (const char*)g.Bt + (size_t)nxt.pn * tstep : cB;
        for (int t = 0; t < nt; t += 2) {
            const bool last = (t == nt - 2);
            const char* a1 = cA + (size_t)(t + 1) * kstep;
            const char* a2 = last ? nA : cA + (size_t)(t + 2) * kstep; const char* b2 = last ? nB : cB + (size_t)(t + 2) * kstep;
            const char* a3 = a2 + kstep; const char* b3 = b2 + kstep;
            if (last && has_next) S.a_ready(nxt);
            if constexpr (SP2) {
            PG8_LDB(B0, 0, 0); PG8_LDB(B1, 0, 1); PG8_SCHED; PG8_LDA(At, 0, 0); PG8_STAGE(PG8_SA(1, 1), a1 + hstep, voffA);
            PG8_WAIT_V(8); PG8_WAIT_L(0); PG8_BAR; PG8_MMA(0, 0, At, B0); PG8_MMA(0, 1, At, B1); PG8_BAR; PG8_SCHED;
            PG8_LDA(At, 0, 1); PG8_STAGE(PG8_SB(0, 0), b2, voffB); PG8_STAGE(PG8_SB(0, 1), b2 + hstep, voffB); PG8_STAGE(PG8_SA(0, 0), a2, voffA);
            PG8_WAIT_V(8); PG8_WAIT_L(0); PG8_BAR; PG8_MMA(1, 0, At, B0); PG8_MMA(1, 1, At, B1); PG8_BAR; PG8_SCHED;
            PG8_LDB(B0, 1, 0); PG8_LDB(B1, 1, 1); PG8_SCHED; PG8_LDA(At, 1, 0); PG8_STAGE(PG8_SA(0, 1), a2 + hstep, voffA);
            PG8_WAIT_V(8); PG8_WAIT_L(0); PG8_BAR; PG8_MMA(0, 0, At, B0); PG8_MMA(0, 1, At, B1); PG8_BAR; PG8_SCHED;
            PG8_LDA(At, 1, 1); PG8_STAGE(PG8_SB(1, 0), b3, voffB); PG8_STAGE(PG8_SB(1, 1), b3 + hstep, voffB); PG8_STAGE(PG8_SA(1, 0), a3, voffA);
            PG8_WAIT_V(8); PG8_WAIT_L(0); PG8_BAR; PG8_MMA(1, 0, At, B0); PG8_MMA(1, 1, At, B1); PG8_BAR; PG8_SCHED;
            } else {
            PG8_LDB(B0, 0, 0); PG8_SCHED; PG8_LDA(At, 0, 0); PG8_STAGE(PG8_SA(1, 1), a1 + hstep, voffA);
            PG8_WAIT_L(8); PG8_BAR; PG8_WAIT_L(0); PG8_MMA(0, 0, At, B0); PG8_BAR; PG8_SCHED;
            PG8_LDB(B1, 0, 1); PG8_STAGE(PG8_SB(0, 0), b2, voffB);
            PG8_BAR; PG8_WAIT_L(0); PG8_MMA(0, 1, At, B1); PG8_BAR;
            PG8_LDA(At, 0, 1); PG8_STAGE(PG8_SA(0, 0), a2, voffA);
            PG8_BAR; PG8_WAIT_L(0); PG8_MMA(1, 0, At, B0); PG8_BAR; PG8_SCHED;
            PG8_STAGE(PG8_SB(0, 1), b2 + hstep, voffB);
            PG8_WAIT_V(6); PG8_BAR; PG8_MMA(1, 1, At, B1); PG8_BAR;
            PG8_LDB(B0, 1, 0); PG8_SCHED; PG8_LDA(At, 1, 0); PG8_STAGE(PG8_SA(0, 1), a2 + hstep, voffA);
            PG8_WAIT_L(8); PG8_BAR; PG8_WAIT_L(0); PG8_MMA(0, 0, At, B0); PG8_BAR; PG8_SCHED;
            PG8_LDB(B1, 1, 1); PG8_STAGE(PG8_SB(1, 0), b3, voffB);
            PG8_BAR; PG8_WAIT_L(0); PG8_MMA(0, 1, At, B1); PG8_BAR;
            PG8_LDA(At, 1, 1); PG8_STAGE(PG8_SA(1, 0), a3, voffA);
            PG8_BAR; PG8_WAIT_L(0); PG8_MMA(1, 0, At, B0); PG8_BAR; PG8_SCHED;
            PG8_STAGE(PG8_SB(1, 1), b3 + hstep, voffB);
            PG8_WAIT_V(6); PG8_BAR; PG8_MMA(1, 1, At, B1); PG8_BAR;
            }
        }
        if constexpr (ALIGN_EPI) { if (wr == 0) PG8_BAR; }
        if constexpr (!Epi::AFTER_DRAIN) { E(acc, cur, wr, wc, fr, fq); S.done(cur); }
        if (!has_next) break;
#pragma unroll
        for (int a = 0; a < 2; ++a)
#pragma unroll
            for (int b = 0; b < 2; ++b)
#pragma unroll
                for (int m = 0; m < 4; ++m)
#pragma unroll
                    for (int n = 0; n < 2; ++n) acc[a][b][m][n] = (f32x4){0.f, 0.f, 0.f, 0.f};
        cur = nxt; cA = nA; cB = nB; ++ui;
        if constexpr (ALIGN_EPI) { if (wr == 1) PG8_BAR; }
    }
    PG8_WAIT_V(0);
    if constexpr (!ALIGN_EPI) { if (wr == 0) PG8_BAR; }
    PG8_BAR;
    if constexpr (Epi::AFTER_DRAIN) { E.fused(acc, cur, wr, wc, fr, fq, lds, wid, lane); S.done(cur); }
#undef PG8_SA
#undef PG8_SB
#undef PG8_STAGE
#undef PG8_LDA
#undef PG8_LDB
#undef PG8_MMA
#undef PG8_WAIT_V
#undef PG8_WAIT_L
#undef PG8_BAR
#undef PG8_SCHED
}
}

using pg8::bf16_t; using pg8::bf16x8; using pg8::f32x4; using pg8::cvt_pk_bf16; using pg8::silu_f;
typedef short bf16x4 __attribute__((ext_vector_type(4)));

constexpr int NTOK = 32768, DM = 2048, SEQ = 8192, LDP = 5632, DFF = 5632, INW = 5648;
constexpr int PXBC = 1024, PAQ = 2560, PAK = 3072, PAV = 3584, PRQ = 4096, PRK = 4352, PRV = 4608, PRG = 5120;
constexpr int LDS_BYTES = 131072 + 16;

constexpr size_t SZ_WIN = (size_t)5632 * 2048 * 2, SZ_WOUT = (size_t)2048 * 2048 * 2, SZ_WGU = (size_t)11264 * 2048 * 2, SZ_WDN = (size_t)2048 * 5632 * 2;
constexpr size_t OFF_WIN = 0, OFF_WOUT = OFF_WIN + 2 * SZ_WIN, OFF_WGU = OFF_WOUT + 2 * SZ_WOUT, OFF_WDN = OFF_WGU + 2 * SZ_WGU;
constexpr size_t OFF_HN = OFF_WDN + 2 * SZ_WDN;
constexpr size_t OFF_Y = OFF_HN + (size_t)NTOK * DM * 2;
constexpr size_t OFF_PROJ = OFF_Y + (size_t)NTOK * DM * 2;
constexpr size_t OFF_SST = OFF_PROJ + (size_t)NTOK * LDP * 2;
constexpr size_t OFF_RST = OFF_SST + (size_t)4096 * 8192 * 2;
constexpr size_t OFF_LSE = OFF_RST + (size_t)1024 * 8192 * 4;
constexpr size_t OFF_DT = OFF_LSE + (size_t)3 * NTOK * 8 * 4;
constexpr size_t OFF_CDEC = OFF_DT + (size_t)NTOK * 16 * 4;
constexpr size_t OFF_ROPE = OFF_CDEC + (size_t)4096 * 4;
constexpr size_t OFF_XC = OFF_ROPE + (size_t)8192 * 32 * 4 * 2;
constexpr size_t OFF_BAR = OFF_XC + (size_t)NTOK * 1536 * 2;
constexpr size_t OFF_RSTD = OFF_BAR + (size_t)XCD_BAR_WORDS * 4;
constexpr size_t WS_END = OFF_RSTD + (size_t)NTOK * 4;

#ifndef REP_PREP
#define REP_PREP 1
#endif
#ifndef REP_NORM
#define REP_NORM 1
#endif
#ifndef REP_INPROJ
#define REP_INPROJ 1
#endif
#ifndef REP_M1
#define REP_M1 1
#endif
#ifndef REP_ATT
#define REP_ATT 1
#endif
#ifndef REP_ST
#define REP_ST 1
#endif
#ifndef REP_GU
#define REP_GU 1
#endif
#ifndef REP_NORM2
#define REP_NORM2 1
#endif
#ifndef REP_SYNC
#define REP_SYNC 0
#endif
#ifndef REP_M3
#define REP_M3 1
#endif
struct Params {
    const float *x, *ln_mix, *w_in, *conv_w, *conv_b, *dt_bias, *a_log, *d_skip, *ssd_norm, *q_norm, *k_norm, *ret_norm, *w_out, *ln_ffn, *w_gate, *w_up, *w_down;
    float* out;
    unsigned char* ws;
};

__device__ __forceinline__ bf16x8 as_bf8(uint4 v) { return __builtin_bit_cast(bf16x8, v); }
__device__ __forceinline__ bf16x8 cat4(bf16x4 a, bf16x4 b) { return __builtin_shufflevector(a, b, 0, 1, 2, 3, 4, 5, 6, 7); }
__device__ __forceinline__ uint4 pack8u(const float* v) { uint4 w; w.x = cvt_pk_bf16(v[0], v[1]); w.y = cvt_pk_bf16(v[2], v[3]); w.z = cvt_pk_bf16(v[4], v[5]); w.w = cvt_pk_bf16(v[6], v[7]); return w; }
__device__ __forceinline__ uint2 pack4u(float a, float b, float c, float d) { uint2 w; w.x = cvt_pk_bf16(a, b); w.y = cvt_pk_bf16(c, d); return w; }
__device__ __forceinline__ void unpack8(uint4 r, float* v) {
    v[0] = __uint_as_float(r.x << 16); v[1] = __uint_as_float(r.x & 0xffff0000u); v[2] = __uint_as_float(r.y << 16); v[3] = __uint_as_float(r.y & 0xffff0000u);
    v[4] = __uint_as_float(r.z << 16); v[5] = __uint_as_float(r.z & 0xffff0000u); v[6] = __uint_as_float(r.w << 16); v[7] = __uint_as_float(r.w & 0xffff0000u); }
__device__ __forceinline__ void unpack4(uint2 r, float* v) {
    v[0] = __uint_as_float(r.x << 16); v[1] = __uint_as_float(r.x & 0xffff0000u); v[2] = __uint_as_float(r.y << 16); v[3] = __uint_as_float(r.y & 0xffff0000u); }
__device__ __forceinline__ bf16_t f2bf(float f) { return (bf16_t)(cvt_pk_bf16(f, 0.f) & 0xffffu); }
__device__ __forceinline__ f32x4 mfma16(bf16x8 a, bf16x8 b, f32x4 c) { return __builtin_amdgcn_mfma_f32_16x16x32_bf16(a, b, c, 0, 0, 0); }
#define F4ZERO ((f32x4){0.f, 0.f, 0.f, 0.f})

struct WtTile { const float* src; const float* gk; bf16_t* dst; int ld, ldd; };
__device__ __forceinline__ WtTile wt_decode(const Params& p, int id) {
    WtTile T; const int layer = id / 12288; int r = id - layer * 12288;
    if (r < 2816) { const int kt = r / 88, nt = r - kt * 88, n0 = nt * 64;
        T.src = p.w_in + (size_t)layer * DM * INW + (size_t)(kt * 64) * INW + (n0 < 2560 ? n0 : n0 + 16); T.ld = INW; T.dst = (bf16_t*)(p.ws + OFF_WIN + layer * SZ_WIN) + (size_t)n0 * DM + kt * 64; T.ldd = DM; T.gk = p.ln_mix + layer * DM + kt * 64; }
    else if ((r -= 2816) < 1024) { const int kt = r >> 5, nt = r & 31;
        T.src = p.w_out + (size_t)layer * DM * DM + (size_t)(kt * 64) * DM + nt * 64; T.ld = DM; T.dst = (bf16_t*)(p.ws + OFF_WOUT + layer * SZ_WOUT) + (size_t)(nt * 64) * DM + kt * 64; T.ldd = DM; T.gk = nullptr; }
    else if ((r -= 1024) < 5632) { const int kt = r / 176, nt = r - kt * 176, n0 = nt * 64, pn = n0 >> 8, bj = (n0 >> 7) & 1, j0 = n0 & 127;
        T.src = (bj ? p.w_up : p.w_gate) + (size_t)layer * DM * DFF + (size_t)(kt * 64) * DFF + pn * 128 + j0; T.ld = DFF; T.dst = (bf16_t*)(p.ws + OFF_WGU + layer * SZ_WGU) + (size_t)n0 * DM + kt * 64; T.ldd = DM; T.gk = p.ln_ffn + layer * DM + kt * 64; }
    else { r -= 5632; const int kt = r >> 5, nt = r & 31;
        T.src = p.w_down + (size_t)layer * DFF * DM + (size_t)(kt * 64) * DM + nt * 64; T.ld = DM; T.dst = (bf16_t*)(p.ws + OFF_WDN + layer * SZ_WDN) + (size_t)(nt * 64) * DFF + kt * 64; T.ldd = DFF; T.gk = nullptr; }
    return T;
}
__device__ __forceinline__ void phase_prep(const Params& p, unsigned char* shm) {
    float* t = (float*)shm;
    int tid0_ = threadIdx.x; asm volatile("" : "+v"(tid0_)); const int tid = tid0_, nn = tid & 63, kk0 = tid >> 6;
    const int NT = 2 * 12288;
    int id = blockIdx.x;
    float r0, r1, r2, r3, r4, r5, r6, r7; r0 = r1 = r2 = r3 = r4 = r5 = r6 = r7 = 0.f;
    WtTile T; T.src = nullptr; T.gk = nullptr; T.dst = nullptr; T.ld = 0; T.ldd = 0;
#define WT_LOAD(TT) do { const float* s_ = (TT).src + (size_t)kk0 * (TT).ld + nn; const size_t st_ = (size_t)8 * (TT).ld; \
        r0 = s_[0]; r1 = s_[st_]; r2 = s_[2 * st_]; r3 = s_[3 * st_]; r4 = s_[4 * st_]; r5 = s_[5 * st_]; r6 = s_[6 * st_]; r7 = s_[7 * st_]; \
        if ((TT).gk) { const float* g_ = (TT).gk + kk0; r0 *= g_[0]; r1 *= g_[8]; r2 *= g_[16]; r3 *= g_[24]; r4 *= g_[32]; r5 *= g_[40]; r6 *= g_[48]; r7 *= g_[56]; } } while (0)
    if (id < NT) { T = wt_decode(p, id); WT_LOAD(T); }
#pragma unroll 1
    for (; id < NT; id += gridDim.x) {
        { float* tp = t + kk0 * 65 + nn; tp[0] = r0; tp[8 * 65] = r1; tp[16 * 65] = r2; tp[24 * 65] = r3; tp[32 * 65] = r4; tp[40 * 65] = r5; tp[48 * 65] = r6; tp[56 * 65] = r7; }
        WtTile Tn = T; const bool more = id + (int)gridDim.x < NT;
        if (more) { Tn = wt_decode(p, id + (int)gridDim.x); WT_LOAD(Tn); }
        __syncthreads();
        { const int kk = (tid & 31) * 2, nn0 = tid >> 5;
#pragma unroll
          for (int i = 0; i < 4; ++i) { const int n2 = nn0 + 16 * i; *(unsigned*)(T.dst + (size_t)n2 * T.ldd + kk) = cvt_pk_bf16(t[kk * 65 + n2], t[(kk + 1) * 65 + n2]); } }
        __syncthreads();
        T = Tn;
    }
#undef WT_LOAD
    float* cosT = (float*)(p.ws + OFF_ROPE); float* sinT = cosT + 8192 * 32;
    for (int e = blockIdx.x * 512 + threadIdx.x; e < 8192 * 32; e += gridDim.x * 512) {
        const int pos = e >> 5, i = e & 31;
        const float inv = (float)exp(-(double)i * (9.210340371976184 / 32.0));
        const float ang = (float)pos * inv;
        const double rev = (double)ang * 0.15915494309189535; const float fr = (float)(rev - rint(rev));
        cosT[e] = __builtin_amdgcn_cosf(fr); sinT[e] = __builtin_amdgcn_sinf(fr);
    }
}

template <bool WITH_DT, bool XF32>
__device__ __forceinline__ void phase_resid(const float* __restrict__ xf, bf16_t* xb, const bf16_t* delta, bf16_t* hn, const float* __restrict__ g, const float* w_in_l, const float* dt_bias, float* dtbuf, unsigned char* shm) {
    int tid0_ = threadIdx.x; asm volatile("" : "+v"(tid0_)); const int tid = tid0_, lane = tid & 63, wid = tid >> 6;
    bf16_t* wlb = (bf16_t*)shm;
    constexpr int RG = WITH_DT ? 16 : 1;
    if (WITH_DT) {
        for (int k = tid; k < 2048; k += 512) {
            const float4* s = (const float4*)(w_in_l + (size_t)k * INW + 2560); const float gk = g[k];
#pragma unroll
            for (int q = 0; q < 4; ++q) { const float4 v = s[q]; wlb[(4 * q + 0) * 2056 + k] = f2bf(v.x * gk); wlb[(4 * q + 1) * 2056 + k] = f2bf(v.y * gk); wlb[(4 * q + 2) * 2056 + k] = f2bf(v.z * gk); wlb[(4 * q + 3) * 2056 + k] = f2bf(v.w * gk); } }
        __syncthreads();
    }
#pragma unroll 1
    for (int rowg = (blockIdx.x * 8 + wid) * RG; rowg < NTOK; rowg += gridDim.x * 8 * RG) {
#pragma unroll 1
        for (int row = rowg; row < rowg + RG; ++row) {
            float4 v[8];
            if (XF32) {
#pragma unroll
                for (int i = 0; i < 8; ++i) v[i] = *(const float4*)(xf + (size_t)row * DM + i * 256 + lane * 4);
            } else {
                uint2 xr[8];
#pragma unroll
                for (int i = 0; i < 8; ++i) xr[i] = *(const uint2*)(xb + (size_t)row * DM + i * 256 + lane * 4);
#pragma unroll
                for (int i = 0; i < 8; ++i) { float x4[4]; unpack4(xr[i], x4); v[i].x = x4[0]; v[i].y = x4[1]; v[i].z = x4[2]; v[i].w = x4[3]; }
            }
            if (delta) {
                uint2 dl[8];
#pragma unroll
                for (int i = 0; i < 8; ++i) dl[i] = *(const uint2*)(delta + (size_t)row * DM + i * 256 + lane * 4);
#pragma unroll
                for (int i = 0; i < 8; ++i) { float d4[4]; unpack4(dl[i], d4); v[i].x += d4[0]; v[i].y += d4[1]; v[i].z += d4[2]; v[i].w += d4[3]; }
            }
            float ss = 0.f;
#pragma unroll
            for (int i = 0; i < 8; ++i) ss += v[i].x * v[i].x + v[i].y * v[i].y + v[i].z * v[i].z + v[i].w * v[i].w;
#pragma unroll
            for (int o = 32; o >= 1; o >>= 1) ss += __shfl_xor(ss, o);
            const float rstd = rsqrtf(ss * (1.0f / DM) + 1e-6f);
#pragma unroll
            for (int i = 0; i < 8; ++i) {
                if (XF32 || delta) *(uint2*)(xb + (size_t)row * DM + i * 256 + lane * 4) = pack4u(v[i].x, v[i].y, v[i].z, v[i].w);
                *(uint2*)(hn + (size_t)row * DM + i * 256 + lane * 4) = pack4u(v[i].x * rstd, v[i].y * rstd, v[i].z * rstd, v[i].w * rstd); }
        }
        if (WITH_DT) {
            const int lr = lane & 15, g4 = lane >> 4;
            __builtin_amdgcn_fence(__ATOMIC_RELEASE, "workgroup"); asm volatile("s_waitcnt vmcnt(0)" ::: "memory"); __builtin_amdgcn_fence(__ATOMIC_ACQUIRE, "workgroup");
            f32x4 acc = F4ZERO;
            const bf16_t* ap = hn + (size_t)(rowg + lr) * DM + g4 * 8; const bf16_t* bp = wlb + lr * 2056 + g4 * 8;
#pragma unroll 8
            for (int ks = 0; ks < 64; ++ks) acc = mfma16(*(const bf16x8*)(ap + ks * 32), *(const bf16x8*)(bp + ks * 32), acc);
            const float bias = dt_bias[lr];
#pragma unroll
            for (int q = 0; q < 4; ++q) { const float xv = acc[q] + bias; dtbuf[(size_t)(rowg + 4 * g4 + q) * 16 + lr] = fmaxf(xv, 0.f) + log1pf(__expf(-fabsf(xv))); }
        }
    }
    __syncthreads();
}

#ifndef GEMM_SP2
#define GEMM_SP2 true
#endif
#ifndef GEMM_ALIGN
#define GEMM_ALIGN true
#endif
template <class Epi>
__device__ __forceinline__ void run_gemm(unsigned char* shm, const bf16_t* A, const bf16_t* Bt, int M, int N, int K, const Epi& E, int vb, unsigned long long* pst = nullptr) {
    pg8::Gemm g; g.A = A; g.Bt = Bt; g.M = M; g.N = N; g.K = K;
    pg8::StaticOrder S; S.init(M, N, (int)gridDim.x, vb);
    (void)pst; pg8::gemm_phase<Epi, pg8::StaticOrder, GEMM_ALIGN, GEMM_SP2>((PG8_LAS unsigned char*)shm, g, S, E);
    __syncthreads();
}

__device__ __forceinline__ void rope8(float* v, const float* cosT, const float* sinT, int t, int sub, float sc) {
    const float* cp = cosT + t * 32 + (sub & 3) * 8; const float* sp = sinT + t * 32 + (sub & 3) * 8;
    const float4 c0 = *(const float4*)cp, c1 = *(const float4*)(cp + 4), s0 = *(const float4*)sp, s1 = *(const float4*)(sp + 4);
    const float cc[8] = {c0.x, c0.y, c0.z, c0.w, c1.x, c1.y, c1.z, c1.w}; const float sn[8] = {s0.x, s0.y, s0.z, s0.w, s1.x, s1.y, s1.z, s1.w};
#pragma unroll
    for (int i = 0; i < 8; ++i) { const float pv = __shfl_xor(v[i], 4); v[i] = ((sub < 4) ? (v[i] * cc[i] - pv * sn[i]) : (pv * sn[i] + v[i] * cc[i])) * sc; }
}
__device__ __forceinline__ void phase_pre(const Params& p, int layer) {
    int tid0_ = threadIdx.x; asm volatile("" : "+v"(tid0_)); const int tid = tid0_;
    bf16_t* proj = (bf16_t*)(p.ws + OFF_PROJ); bf16_t* xc = (bf16_t*)(p.ws + OFF_XC);
    const float* cosT = (const float*)(p.ws + OFF_ROPE); const float* sinT = cosT + 8192 * 32;
    const float* cw = p.conv_w + layer * 4 * 1536; const float* cb = p.conv_b + layer * 1536;
    for (int it = blockIdx.x; it < 256; it += gridDim.x) {
        if (tid < 384) {
            const int cg = tid % 192, half = tid / 192, ch = cg * 8, c = it & 63, l0 = half * 64;
            const size_t tokbase = (size_t)it * 128;
            float wk[4][8], bias[8];
            { const float4 b0 = *(const float4*)(cb + ch), b1 = *(const float4*)(cb + ch + 4); bias[0] = b0.x; bias[1] = b0.y; bias[2] = b0.z; bias[3] = b0.w; bias[4] = b1.x; bias[5] = b1.y; bias[6] = b1.z; bias[7] = b1.w; }
#pragma unroll
            for (int k = 0; k < 4; ++k) { const float4 w0 = *(const float4*)(cw + k * 1536 + ch), w1 = *(const float4*)(cw + k * 1536 + ch + 4);
                wk[k][0] = w0.x; wk[k][1] = w0.y; wk[k][2] = w0.z; wk[k][3] = w0.w; wk[k][4] = w1.x; wk[k][5] = w1.y; wk[k][6] = w1.z; wk[k][7] = w1.w; }
            float h0[8], h1[8], h2[8];
            { uint4 r0 = make_uint4(0u, 0u, 0u, 0u), r1 = r0, r2 = r0;
              if (c * 128 + l0 - 3 >= 0) { r0 = *(const uint4*)(proj + (tokbase + l0 - 3) * LDP + PXBC + ch); r1 = *(const uint4*)(proj + (tokbase + l0 - 2) * LDP + PXBC + ch); r2 = *(const uint4*)(proj + (tokbase + l0 - 1) * LDP + PXBC + ch); }
              unpack8(r0, h0); unpack8(r1, h1); unpack8(r2, h2); }
#pragma unroll 1
            for (int lb = 0; lb < 64; lb += 8) {
                uint4 raw[8];
#pragma unroll
                for (int i = 0; i < 8; ++i) raw[i] = *(const uint4*)(proj + (tokbase + l0 + lb + i) * LDP + PXBC + ch);
#pragma unroll
                for (int i = 0; i < 8; ++i) { float xv[8], o[8]; unpack8(raw[i], xv);
#pragma unroll
                    for (int e = 0; e < 8; ++e) { o[e] = silu_f(bias[e] + wk[0][e] * h0[e] + wk[1][e] * h1[e] + wk[2][e] * h2[e] + wk[3][e] * xv[e]); h0[e] = h1[e]; h1[e] = h2[e]; h2[e] = xv[e]; }
                    *(uint4*)(xc + (tokbase + l0 + lb + i) * 1536 + ch) = pack8u(o); }
            }
        }
    }
    const int sub = tid & 7, grp = (blockIdx.x * 512 + tid) >> 3, ngrp = gridDim.x * 64;
    const float* qg = p.q_norm + layer * 64; const float* kg = p.k_norm + layer * 64;
#pragma unroll 4
    for (int rt = grp; rt < NTOK * 16; rt += ngrp) {
        const int tok = rt >> 4, hk = rt & 15; bf16_t* ptr = proj + (size_t)tok * LDP + PAQ + hk * 64 + sub * 8;
        float v[8]; unpack8(*(const uint4*)ptr, v);
        float ss = 0.f;
#pragma unroll
        for (int i = 0; i < 8; ++i) ss += v[i] * v[i];
        ss += __shfl_xor(ss, 1); ss += __shfl_xor(ss, 2); ss += __shfl_xor(ss, 4);
        const float rstd = rsqrtf(ss * (1.0f / 64.0f) + 1e-6f);
        const float* gp = (hk < 8 ? qg : kg) + sub * 8; const float4 g0 = *(const float4*)gp, g1 = *(const float4*)(gp + 4);
        v[0] *= rstd * g0.x; v[1] *= rstd * g0.y; v[2] *= rstd * g0.z; v[3] *= rstd * g0.w; v[4] *= rstd * g1.x; v[5] *= rstd * g1.y; v[6] *= rstd * g1.z; v[7] *= rstd * g1.w;
        rope8(v, cosT, sinT, tok & (SEQ - 1), sub, hk < 8 ? 0.125f : 1.0f);
        *(uint4*)ptr = pack8u(v);
    }
#pragma unroll 4
    for (int rt = grp; rt < NTOK * 8; rt += ngrp) {
        const int tok = rt >> 3, hk = rt & 7; bf16_t* ptr = proj + (size_t)tok * LDP + PRQ + hk * 64 + sub * 8;
        float v[8]; unpack8(*(const uint4*)ptr, v);
        rope8(v, cosT, sinT, tok & (SEQ - 1), sub, hk < 4 ? 1.0f : 0.125f);
        *(uint4*)ptr = pack8u(v);
    }
}

template <int W>
__device__ __forceinline__ void stage_tr(const bf16_t* __restrict__ src, int ld, size_t tokbase, bf16_t* dst, int stride, const float* rs, int tid) {
    const int l = tid & 127, cgi = tid >> 7;
    uint4 raw[W / 32];
#pragma unroll
    for (int it = 0; it < W / 32; ++it) raw[it] = *(const uint4*)(src + (tokbase + l) * ld + cgi * 8 + 32 * it);
    if (rs) { const float sc = rs[l];
#pragma unroll
        for (int it = 0; it < W / 32; ++it) { float v[8]; unpack8(raw[it], v);
#pragma unroll
            for (int i = 0; i < 8; ++i) v[i] *= sc;
            raw[it] = pack8u(v); } }
#pragma unroll
    for (int it = 0; it < W / 32; ++it) { bf16_t* vp = dst + (cgi * 8 + 32 * it) * stride + l; const uint4 r = raw[it];
        vp[0] = (bf16_t)(r.x & 0xffffu); vp[stride] = (bf16_t)(r.x >> 16); vp[2 * stride] = (bf16_t)(r.y & 0xffffu); vp[3 * stride] = (bf16_t)(r.y >> 16);
        vp[4 * stride] = (bf16_t)(r.z & 0xffffu); vp[5 * stride] = (bf16_t)(r.z >> 16); vp[6 * stride] = (bf16_t)(r.w & 0xffffu); vp[7 * stride] = (bf16_t)(r.w >> 16); }
}
template <int W>
__device__ __forceinline__ void stage_nat(const bf16_t* __restrict__ src, int ld, size_t tokbase, bf16_t* dst, int stride, int tid) {
    constexpr int CG = W / 8, RP = 512 / CG, NP = 128 / RP;
    const int cg = tid % CG, r0 = tid / CG;
    uint4 raw[NP];
#pragma unroll
    for (int it = 0; it < NP; ++it) raw[it] = *(const uint4*)(src + (tokbase + r0 + it * RP) * ld + cg * 8);
#pragma unroll
    for (int it = 0; it < NP; ++it) *(uint4*)(dst + (r0 + it * RP) * stride + cg * 8) = raw[it];
}

__device__ __forceinline__ float head_acum(const float* __restrict__ dtbuf, size_t tokbase, int hh, float a_neg, int lane, float& d0, float& d1, float& ac0, float& ac1) {
    const int l0 = 2 * lane;
    d0 = dtbuf[(tokbase + l0) * 16 + hh]; d1 = dtbuf[(tokbase + l0 + 1) * 16 + hh];
    const float v0 = d0 * a_neg, v1 = d1 * a_neg; float s = v0 + v1;
#pragma unroll
    for (int o = 1; o < 64; o <<= 1) { const float t = __shfl_up(s, o); if (lane >= o) s += t; }
    ac0 = s - v1; ac1 = s;
    return __shfl(s, 63);
}

struct AttId { int b, h, br, d, r, n; };
__device__ __forceinline__ AttId att_decode(int idx) {
    AttId a; a.br = idx >> 11; const int rem = idx & 2047, bh = rem >> 6, jj = rem & 63, dsh = 2 * a.br;
    a.d = 1 << dsh; a.r = jj >> (6 - dsh); a.n = jj & ((64 >> dsh) - 1); a.b = bh >> 3; a.h = bh & 7; return a;
}
__device__ __forceinline__ void att_run(const Params& p, int u0, int cnt, unsigned char* shm) {
    int tid0_ = threadIdx.x; asm volatile("" : "+v"(tid0_)); const int tid = tid0_, lane = tid & 63, w = __builtin_amdgcn_readfirstlane(tid >> 6), lr = lane & 15, g4 = lane >> 4;
    if (cnt <= 0) return;
    bf16_t* Qs = (bf16_t*)shm; bf16_t* Ks = Qs + 128 * 72; bf16_t* Vt = Ks + 256 * 72;
    const bf16_t* proj = (const bf16_t*)(p.ws + OFF_PROJ);
    const int sub = tid & 7, rloc = tid >> 3;
    AttId a = att_decode(u0);
    uint4 rq0, rq1, rk0, rk1, rv0, rv1;
    { const bf16_t* base = proj + ((size_t)a.b * SEQ + a.r) * LDP + a.h * 64 + sub * 8; const size_t rs = (size_t)a.d * LDP;
      { const bf16_t* rp = base + (size_t)(a.n * 128 + rloc) * rs; rq0 = *(const uint4*)(rp + PAQ); rk0 = *(const uint4*)(rp + PAK); rv0 = *(const uint4*)(rp + PAV); }
      { const bf16_t* rp = base + (size_t)(a.n * 128 + 64 + rloc) * rs; rq1 = *(const uint4*)(rp + PAQ); rk1 = *(const uint4*)(rp + PAK); rv1 = *(const uint4*)(rp + PAV); }
      if (a.n > 0) {
          const int ps_slot = (a.n - 1) & 1;
#pragma unroll
          for (int ps = 0; ps < 2; ++ps) { const int li = ps * 64 + rloc; const bf16_t* rp = base + (size_t)((a.n - 1) * 128 + li) * rs;
              const uint4 k = *(const uint4*)(rp + PAK), v = *(const uint4*)(rp + PAV);
              *(uint4*)(Ks + (ps_slot * 128 + li) * 72 + sub * 8) = k;
              bf16_t* vp = Vt + (sub * 8) * 264 + ps_slot * 128 + li;
              vp[0] = (bf16_t)(v.x & 0xffffu); vp[264] = (bf16_t)(v.x >> 16); vp[528] = (bf16_t)(v.y & 0xffffu); vp[792] = (bf16_t)(v.y >> 16);
              vp[1056] = (bf16_t)(v.z & 0xffffu); vp[1320] = (bf16_t)(v.z >> 16); vp[1584] = (bf16_t)(v.w & 0xffffu); vp[1848] = (bf16_t)(v.w >> 16); } } }
#pragma unroll 1
    for (int k = 0; k < cnt; ++k) {
        const int slot = a.n & 1;
        if (a.n == 0) { const uint4 z = make_uint4(0u, 0u, 0u, 0u); bf16_t* zp = Vt + (tid >> 3) * 264 + 128 + (tid & 7) * 16; *(uint4*)zp = z; *(uint4*)(zp + 8) = z; }
#pragma unroll
        for (int ps = 0; ps < 2; ++ps) { const int li = ps * 64 + rloc;
            *(uint4*)(Qs + li * 72 + sub * 8) = ps ? rq1 : rq0; *(uint4*)(Ks + (slot * 128 + li) * 72 + sub * 8) = ps ? rk1 : rk0;
            bf16_t* vp = Vt + (sub * 8) * 264 + slot * 128 + li; const uint4 v = ps ? rv1 : rv0;
            vp[0] = (bf16_t)(v.x & 0xffffu); vp[264] = (bf16_t)(v.x >> 16); vp[528] = (bf16_t)(v.y & 0xffffu); vp[792] = (bf16_t)(v.y >> 16);
            vp[1056] = (bf16_t)(v.z & 0xffffu); vp[1320] = (bf16_t)(v.z >> 16); vp[1584] = (bf16_t)(v.w & 0xffffu); vp[1848] = (bf16_t)(v.w >> 16); }
        const bool has_next = (k + 1 < cnt);
        AttId nx = a;
        if (has_next) { nx = att_decode(u0 + k + 1);
            const bf16_t* base = proj + ((size_t)nx.b * SEQ + nx.r) * LDP + nx.h * 64 + sub * 8; const size_t rs = (size_t)nx.d * LDP;
            { const bf16_t* rp = base + (size_t)(nx.n * 128 + rloc) * rs; rq0 = *(const uint4*)(rp + PAQ); rk0 = *(const uint4*)(rp + PAK); rv0 = *(const uint4*)(rp + PAV); }
            { const bf16_t* rp = base + (size_t)(nx.n * 128 + 64 + rloc) * rs; rq1 = *(const uint4*)(rp + PAQ); rk1 = *(const uint4*)(rp + PAK); rv1 = *(const uint4*)(rp + PAV); } }
        __syncthreads();
        const int iq = 16 * w + lr, n = a.n;
        bf16x8 qf[2];
#pragma unroll
        for (int ks = 0; ks < 2; ++ks) qf[ks] = *(const bf16x8*)(Qs + iq * 72 + ks * 32 + g4 * 8);
        f32x4 s[9]; float mx = -INFINITY;
#pragma unroll
        for (int i = 0; i < 9; ++i) { f32x4 acc = F4ZERO; const int T = w + i; const int krow = (((T < 8) ? (slot ^ 1) : slot) * 128) + (T & 7) * 16 + lr;
#pragma unroll
            for (int ks = 0; ks < 2; ++ks) acc = mfma16(*(const bf16x8*)(Ks + krow * 72 + ks * 32 + g4 * 8), qf[ks], acc);
#pragma unroll
            for (int q = 0; q < 4; ++q) {
                const int dq = 4 * g4 + q - lr; bool ok = (i == 0) ? (dq >= 0) : ((i == 8) ? (dq <= 0) : true);
                if (n == 0) ok = ok && (T >= 8);
                acc[q] = ok ? acc[q] : -INFINITY; mx = fmaxf(mx, acc[q]); }
            s[i] = acc; }
        mx = fmaxf(mx, __shfl_xor(mx, 16)); mx = fmaxf(mx, __shfl_xor(mx, 32));
        float den = 0.f; const float mx2 = mx * 1.4426950408889634f;
#pragma unroll
        for (int i = 0; i < 9; ++i)
#pragma unroll
            for (int q = 0; q < 4; ++q) { const float e = __builtin_amdgcn_exp2f(__builtin_fmaf(s[i][q], 1.4426950408889634f, -mx2)); s[i][q] = e; den += e; }
        den += __shfl_xor(den, 16); den += __shfl_xor(den, 32);
        f32x4 o[4] = {F4ZERO, F4ZERO, F4ZERO, F4ZERO};
#pragma unroll
        for (int pi = 0; pi < 5; ++pi) {
            const f32x4 p0 = s[2 * pi], p1 = (2 * pi + 1 < 9) ? s[(2 * pi + 1 < 9) ? 2 * pi + 1 : 0] : F4ZERO;
            uint4 pw; pw.x = cvt_pk_bf16(p0[0], p0[1]); pw.y = cvt_pk_bf16(p0[2], p0[3]); pw.z = cvt_pk_bf16(p1[0], p1[1]); pw.w = cvt_pk_bf16(p1[2], p1[3]);
            const bf16x8 pf = as_bf8(pw);
            const int T0 = w + 2 * pi, T1 = (T0 + 1 < 16) ? T0 + 1 : 15;
            const int c0 = (((T0 < 8) ? (slot ^ 1) : slot) * 128) + (T0 & 7) * 16 + 4 * g4, c1 = (((T1 < 8) ? (slot ^ 1) : slot) * 128) + (T1 & 7) * 16 + 4 * g4;
#pragma unroll
            for (int dt = 0; dt < 4; ++dt) { const bf16_t* vr = Vt + (dt * 16 + lr) * 264;
                o[dt] = mfma16(cat4(*(const bf16x4*)(vr + c0), *(const bf16x4*)(vr + c1)), pf, o[dt]); }
        }
        const float inv = 1.0f / den;
        const size_t tok = (size_t)a.b * SEQ + (size_t)(n * 128 + iq) * a.d + a.r;
        bf16_t* op = (bf16_t*)p.out + ((size_t)a.br * NTOK + tok) * 512 + a.h * 64;
#pragma unroll
        for (int dt = 0; dt < 4; ++dt) *(uint2*)(op + dt * 16 + 4 * g4) = pack4u(o[dt][0] * inv, o[dt][1] * inv, o[dt][2] * inv, o[dt][3] * inv);
        if (g4 == 0) ((float*)(p.ws + OFF_LSE))[((size_t)a.br * NTOK + tok) * 8 + a.h] = mx + __logf(den);
        __syncthreads();
        a = nx;
    }
}

__device__ __forceinline__ void ssd_state_item(const Params& p, int layer, int idx, unsigned char* shm) {
    int tid0_ = threadIdx.x; asm volatile("" : "+v"(tid0_)); const int tid = tid0_, lane = tid & 63, w = __builtin_amdgcn_readfirstlane(tid >> 6), lr = lane & 15, g4 = lane >> 4;
    const int g = idx & 1, bc = idx >> 1;
    const size_t tokbase = (size_t)bc * 128;
    bf16_t* Bt = (bf16_t*)shm; bf16_t* Xt = Bt + 128 * 136; float* wsc = (float*)(shm + 52224);
    const bf16_t* xc = (const bf16_t*)(p.ws + OFF_XC);
    const float* dtbuf = (const float*)(p.ws + OFF_DT);
    { const int hh = 8 * g + w; float d0, d1, a0, a1;
      const float tot = head_acum(dtbuf, tokbase, hh, -__expf(p.a_log[layer * 16 + hh]), lane, d0, d1, a0, a1);
      wsc[w * 128 + 2 * lane] = __expf(tot - a0) * d0; wsc[w * 128 + 2 * lane + 1] = __expf(tot - a1) * d1;
      if (lane == 0) ((float*)(p.ws + OFF_CDEC))[bc * 16 + hh] = __expf(tot); }
    const int sl = tid & 127, scg = tid >> 7;
    uint4 xa, xb2;
    { const bf16_t* xs = xc + (tokbase + sl) * 1536 + (8 * g) * 64 + scg * 8; xa = *(const uint4*)xs; xb2 = *(const uint4*)(xs + 32); }
    stage_tr<128>(xc + 1024 + g * 128, 1536, tokbase, Bt, 136, nullptr, tid);
#pragma unroll 1
    for (int j = 0; j < 8; ++j) {
        const int hh = 8 * g + j;
        __syncthreads();
        { const float sc = wsc[j * 128 + sl];
#pragma unroll
          for (int it = 0; it < 2; ++it) { float v[8]; unpack8(it ? xb2 : xa, v);
#pragma unroll
              for (int i = 0; i < 8; ++i) Xt[(scg * 8 + 32 * it + i) * 136 + sl] = f2bf(v[i] * sc); } }
        if (j < 7) { const bf16_t* xs = xc + (tokbase + sl) * 1536 + (hh + 1) * 64 + scg * 8; xa = *(const uint4*)xs; xb2 = *(const uint4*)(xs + 32); }
        __syncthreads();
        f32x4 acc[4] = {F4ZERO, F4ZERO, F4ZERO, F4ZERO};
#pragma unroll
        for (int ks = 0; ks < 4; ++ks) { const bf16x8 af = *(const bf16x8*)(Bt + (w * 16 + lr) * 136 + ks * 32 + g4 * 8);
#pragma unroll
            for (int pt = 0; pt < 4; ++pt) acc[pt] = mfma16(af, *(const bf16x8*)(Xt + (pt * 16 + lr) * 136 + ks * 32 + g4 * 8), acc[pt]); }
        bf16_t* sp = (bf16_t*)(p.ws + OFF_SST) + ((size_t)bc * 16 + hh) * 8192;
#pragma unroll
        for (int pt = 0; pt < 4; ++pt) *(uint2*)(sp + (pt * 16 + lr) * 128 + w * 16 + 4 * g4) = pack4u(acc[pt][0], acc[pt][1], acc[pt][2], acc[pt][3]);
    }
    __syncthreads();
}

__device__ __forceinline__ void ret_state_item(const Params& p, int idx, unsigned char* shm) {
    int tid0_ = threadIdx.x; asm volatile("" : "+v"(tid0_)); const int tid = tid0_, lane = tid & 63, w = __builtin_amdgcn_readfirstlane(tid >> 6), lr = lane & 15, g4 = lane >> 4;
    const int h = idx & 3, bc = idx >> 2;
    const size_t tokbase = (size_t)bc * 128;
    bf16_t* Kt = (bf16_t*)shm; bf16_t* Vt = Kt + 64 * 136; float* wsc = (float*)(shm + 52224);
    const bf16_t* proj = (const bf16_t*)(p.ws + OFF_PROJ);
    const float lg = log1pf(-exp2f(-5.0f - (float)h));
    if (tid < 128) wsc[tid] = __expf((float)(127 - tid) * lg);
    stage_tr<128>(proj + PRV + h * 128, LDP, tokbase, Vt, 136, nullptr, tid);
    __syncthreads();
    stage_tr<64>(proj + PRK + h * 64, LDP, tokbase, Kt, 136, wsc, tid);
    __syncthreads();
    f32x4 acc[4] = {F4ZERO, F4ZERO, F4ZERO, F4ZERO};
#pragma unroll
    for (int ks = 0; ks < 4; ++ks) { const bf16x8 bfr = *(const bf16x8*)(Vt + (w * 16 + lr) * 136 + ks * 32 + g4 * 8);
#pragma unroll
        for (int dt = 0; dt < 4; ++dt) acc[dt] = mfma16(*(const bf16x8*)(Kt + (dt * 16 + lr) * 136 + ks * 32 + g4 * 8), bfr, acc[dt]); }
    float* rp = (float*)(p.ws + OFF_RST) + ((size_t)bc * 4 + h) * 8192 + (w * 16 + lr) * 64;
#pragma unroll
    for (int dt = 0; dt < 4; ++dt) *(f32x4*)(rp + dt * 16 + 4 * g4) = acc[dt];
    __syncthreads();
}
__device__ __forceinline__ void phase_scan(const Params& p) {
    int tid0_ = threadIdx.x; asm volatile("" : "+v"(tid0_)); const int nth = gridDim.x * 512, gid = blockIdx.x * 512 + tid0_;
    const float* cdec = (const float*)(p.ws + OFF_CDEC);
    for (int it = gid; it < 131072; it += nth) {
        const int n4 = it & 31, pp = (it >> 5) & 63, hh = (it >> 11) & 15, b = it >> 15;
        const int rd = it & 63, re = (it >> 6) & 127, rh = (it >> 13) & 3;
        float st[4] = {0.f, 0.f, 0.f, 0.f}; float rs = 0.f;
        const float rdec = __expf(128.0f * log1pf(-exp2f(-5.0f - (float)rh)));
        bf16_t* base = (bf16_t*)(p.ws + OFF_SST) + ((size_t)(b * 64) * 16 + hh) * 8192 + pp * 128 + n4 * 4;
        float* rbase = (float*)(p.ws + OFF_RST) + ((size_t)(b * 64) * 4 + rh) * 8192 + re * 64 + rd;
#pragma unroll 8
        for (int c = 0; c < 64; ++c) {
            uint2* a = (uint2*)(base + (size_t)c * 16 * 8192); const uint2 raw = *a; const float dec = cdec[(b * 64 + c) * 16 + hh];
            float* ra = rbase + (size_t)c * 4 * 8192; const float rv = *ra;
            float v[4]; unpack4(raw, v);
            *a = pack4u(st[0], st[1], st[2], st[3]); *ra = rs;
            st[0] = st[0] * dec + v[0]; st[1] = st[1] * dec + v[1]; st[2] = st[2] * dec + v[2]; st[3] = st[3] * dec + v[3];
            rs = rs * rdec + rv;
        }
    }
    const bf16_t* ao = (const bf16_t*)p.out; const float* lse = (const float*)(p.ws + OFF_LSE); bf16_t* y = (bf16_t*)(p.ws + OFF_Y);
    for (int it = gid; it < NTOK * 64; it += nth) {
        const int sub = it & 7, h = (it >> 3) & 7, tok = it >> 6;
        const float l0 = lse[(size_t)tok * 8 + h], l1 = lse[((size_t)NTOK + tok) * 8 + h], l2 = lse[((size_t)2 * NTOK + tok) * 8 + h];
        const float m = fmaxf(l0, fmaxf(l1, l2)); float w0 = __expf(l0 - m), w1 = __expf(l1 - m), w2 = __expf(l2 - m); const float inv = 1.0f / (w0 + w1 + w2); w0 *= inv; w1 *= inv; w2 *= inv;
        float a0[8], a1[8], a2[8], o[8];
        unpack8(*(const uint4*)(ao + (size_t)tok * 512 + h * 64 + sub * 8), a0);
        unpack8(*(const uint4*)(ao + ((size_t)NTOK + tok) * 512 + h * 64 + sub * 8), a1);
        unpack8(*(const uint4*)(ao + ((size_t)2 * NTOK + tok) * 512 + h * 64 + sub * 8), a2);
#pragma unroll
        for (int i = 0; i < 8; ++i) o[i] = w0 * a0[i] + w1 * a1[i] + w2 * a2[i];
        *(uint4*)(y + (size_t)tok * DM + 1024 + h * 64 + sub * 8) = pack8u(o);
    }
}

__device__ __forceinline__ void ssd_out_item(const Params& p, int layer, int idx, unsigned char* shm) {
    int tid0_ = threadIdx.x; asm volatile("" : "+v"(tid0_)); const int tid = tid0_, lane = tid & 63, w = __builtin_amdgcn_readfirstlane(tid >> 6), lr = lane & 15, g4 = lane >> 4;
    const int g = idx & 1, bc = idx >> 1;
    const size_t tokbase = (size_t)bc * 128;
    bf16_t* Cs = (bf16_t*)shm; bf16_t* Bs = Cs + 128 * 136; bf16_t* Xt = Bs + 128 * 136; bf16_t* Pv = Xt + 64 * 136;
    float* dts = (float*)(shm + 104448); float* acs = dts + 8 * 128;
    const bf16_t* proj = (const bf16_t*)(p.ws + OFF_PROJ); const bf16_t* xc = (const bf16_t*)(p.ws + OFF_XC);
    const float* dtbuf = (const float*)(p.ws + OFF_DT);
    bf16_t* y = (bf16_t*)(p.ws + OFF_Y);
    const int sl = tid & 127, scg = tid >> 7;
    uint4 xr0, xr1, pr0, pr1;
    { const bf16_t* xs = xc + (tokbase + sl) * 1536 + (8 * g) * 64 + scg * 8; xr0 = *(const uint4*)xs; xr1 = *(const uint4*)(xs + 32);
      const bf16_t* ps = (const bf16_t*)(p.ws + OFF_SST) + ((size_t)bc * 16 + 8 * g) * 8192 + tid * 8; pr0 = *(const uint4*)ps; pr1 = *(const uint4*)(ps + 4096); }
    { const int hh = 8 * g + w; float d0, d1, a0, a1;
      (void)head_acum(dtbuf, tokbase, hh, -__expf(p.a_log[layer * 16 + hh]), lane, d0, d1, a0, a1);
      dts[w * 128 + 2 * lane] = d0; dts[w * 128 + 2 * lane + 1] = d1; acs[w * 128 + 2 * lane] = a0; acs[w * 128 + 2 * lane + 1] = a1; }
    stage_nat<128>(xc + 1280 + g * 128, 1536, tokbase, Cs, 136, tid);
    stage_nat<128>(xc + 1024 + g * 128, 1536, tokbase, Bs, 136, tid);
    __syncthreads();
    const int l = w * 16 + lr;
    bf16x8 cf[4];
#pragma unroll
    for (int ks = 0; ks < 4; ++ks) cf[ks] = *(const bf16x8*)(Cs + l * 136 + ks * 32 + g4 * 8);
    f32x4 cbt[8];
#pragma unroll
    for (int st = 0; st < 8; ++st) { cbt[st] = F4ZERO;
        if (st <= w) {
#pragma unroll
            for (int ks = 0; ks < 4; ++ks) cbt[st] = mfma16(*(const bf16x8*)(Bs + (st * 16 + lr) * 136 + ks * 32 + g4 * 8), cf[ks], cbt[st]); } }
    float ssq = 0.f;
    const size_t tok = tokbase + l;
#pragma unroll 1
    for (int j = 0; j < 8; ++j) {
        const int hh = 8 * g + j;
        __syncthreads();
#pragma unroll
        for (int it = 0; it < 2; ++it) { bf16_t* vp = Xt + (scg * 8 + 32 * it) * 136 + sl; const uint4 r = it ? xr1 : xr0;
            vp[0] = (bf16_t)(r.x & 0xffffu); vp[136] = (bf16_t)(r.x >> 16); vp[272] = (bf16_t)(r.y & 0xffffu); vp[408] = (bf16_t)(r.y >> 16);
            vp[544] = (bf16_t)(r.z & 0xffffu); vp[680] = (bf16_t)(r.z >> 16); vp[816] = (bf16_t)(r.w & 0xffffu); vp[952] = (bf16_t)(r.w >> 16);
            const int e = tid * 8 + it * 4096; *(uint4*)(Pv + (e >> 7) * 136 + (e & 127)) = it ? pr1 : pr0; }
        if (j < 7) { const bf16_t* xs = xc + (tokbase + sl) * 1536 + (hh + 1) * 64 + scg * 8; xr0 = *(const uint4*)xs; xr1 = *(const uint4*)(xs + 32);
            const bf16_t* ps = (const bf16_t*)(p.ws + OFF_SST) + ((size_t)bc * 16 + hh + 1) * 8192 + tid * 8; pr0 = *(const uint4*)ps; pr1 = *(const uint4*)(ps + 4096); }
        __syncthreads();
        const float* dth = dts + j * 128; const float* ach = acs + j * 128;
        const float al = ach[l], dsk = p.d_skip[layer * 16 + hh];
        uint2 zr[4];
#pragma unroll
        for (int pt = 0; pt < 4; ++pt) zr[pt] = *(const uint2*)(proj + tok * LDP + hh * 64 + pt * 16 + 4 * g4);
        f32x4 acc[4] = {F4ZERO, F4ZERO, F4ZERO, F4ZERO};
#pragma unroll
        for (int sp = 0; sp < 4; ++sp) {
            if (2 * sp <= w) {
                float m[8];
#pragma unroll
                for (int half = 0; half < 2; ++half) { const int T = 2 * sp + half;
                    const float4 av = *(const float4*)(ach + T * 16 + 4 * g4), dv = *(const float4*)(dth + T * 16 + 4 * g4);
                    const float aa[4] = {av.x, av.y, av.z, av.w}, dd[4] = {dv.x, dv.y, dv.z, dv.w};
#pragma unroll
                    for (int q = 0; q < 4; ++q) { const int s = T * 16 + 4 * g4 + q; float mv = (s <= l) ? cbt[T][q] * __expf(al - aa[q]) * dd[q] : 0.f; if (s == l) mv += dsk; m[half * 4 + q] = mv; } }
                const bf16x8 pf = as_bf8(pack8u(m));
#pragma unroll
                for (int pt = 0; pt < 4; ++pt) { const bf16_t* vp = Xt + (pt * 16 + lr) * 136 + (2 * sp) * 16 + 4 * g4;
                    acc[pt] = mfma16(cat4(*(const bf16x4*)vp, *(const bf16x4*)(vp + 16)), pf, acc[pt]); }
            }
        }
        f32x4 off[4] = {F4ZERO, F4ZERO, F4ZERO, F4ZERO};
#pragma unroll
        for (int ks = 0; ks < 4; ++ks)
#pragma unroll
            for (int pt = 0; pt < 4; ++pt) off[pt] = mfma16(*(const bf16x8*)(Pv + (pt * 16 + lr) * 136 + ks * 32 + g4 * 8), cf[ks], off[pt]);
        const float ea = __expf(al);
#pragma unroll
        for (int pt = 0; pt < 4; ++pt) { const int col = hh * 64 + pt * 16 + 4 * g4;
            float z[4]; unpack4(zr[pt], z);
            float yv[4];
#pragma unroll
            for (int q = 0; q < 4; ++q) { yv[q] = (acc[pt][q] + off[pt][q] * ea) * silu_f(z[q]); ssq += yv[q] * yv[q]; }
            *(uint2*)(y + tok * DM + col) = pack4u(yv[0], yv[1], yv[2], yv[3]); }
    }
    ssq += __shfl_xor(ssq, 16); ssq += __shfl_xor(ssq, 32);
    const float scale = rsqrtf(ssq * (1.0f / 512.0f) + 1e-6f);
    const float* nw = p.ssd_norm + layer * 1024;
#pragma unroll 1
    for (int j = 0; j < 8; ++j)
#pragma unroll
        for (int pt = 0; pt < 4; ++pt) { const int col = (8 * g + j) * 64 + pt * 16 + 4 * g4;
            float yv[4]; unpack4(*(const uint2*)(y + tok * DM + col), yv); const float4 nv = *(const float4*)(nw + col);
            *(uint2*)(y + tok * DM + col) = pack4u(yv[0] * scale * nv.x, yv[1] * scale * nv.y, yv[2] * scale * nv.z, yv[3] * scale * nv.w); }
    __syncthreads();
}

__device__ __forceinline__ void ssd_out_item2(const Params& p, int layer, int idx, unsigned char* shm) {
    int tid0_ = threadIdx.x; asm volatile("" : "+v"(tid0_)); const int tid = tid0_, lane = tid & 63, w = __builtin_amdgcn_readfirstlane(tid >> 6), lr = lane & 15, g4 = lane >> 4;
    const int g = idx & 1, bc = idx >> 1, hh = 8 * g + w;
    const size_t tokbase = (size_t)bc * 128;
    float* cbt = (float*)shm;
    float* dts = (float*)(shm + 36864); float* acs = dts + 8 * 128;
    float* ssqp = (float*)(shm + 45056);
    bf16_t* Cs = (bf16_t*)(shm + 49152);
    bf16_t* Bs = Cs + 128 * 136;
    bf16_t* xt = Bs + w * (64 * 40);
    const bf16_t* proj = (const bf16_t*)(p.ws + OFF_PROJ); const bf16_t* xc = (const bf16_t*)(p.ws + OFF_XC);
    bf16_t* y = (bf16_t*)(p.ws + OFF_Y);
    { float d0, d1, a0, a1;
      (void)head_acum((const float*)(p.ws + OFF_DT), tokbase, hh, -__expf(p.a_log[layer * 16 + hh]), lane, d0, d1, a0, a1);
      const float a0s = a0 * 1.4426950408889634f, a1s = a1 * 1.4426950408889634f;
      dts[w * 128 + 2 * lane] = __log2f(d0) - a0s; dts[w * 128 + 2 * lane + 1] = __log2f(d1) - a1s; acs[w * 128 + 2 * lane] = a0s; acs[w * 128 + 2 * lane + 1] = a1s; }
    stage_nat<128>(xc + 1280 + g * 128, 1536, tokbase, Cs, 136, tid);
    stage_nat<128>(xc + 1024 + g * 128, 1536, tokbase, Bs, 136, tid);
    bf16x8 pv[4][4];
    { const bf16_t* ps = (const bf16_t*)(p.ws + OFF_SST) + ((size_t)bc * 16 + hh) * 8192 + lr * 128 + g4 * 8;
#pragma unroll
      for (int ks = 0; ks < 4; ++ks)
#pragma unroll
          for (int pt = 0; pt < 4; ++pt) pv[ks][pt] = *(const bf16x8*)(ps + pt * 16 * 128 + ks * 32); }
    uint4 xraw[4][4];
    { const int xr = lane >> 1, xh = lane & 1;
#pragma unroll
      for (int sp = 0; sp < 4; ++sp) { const bf16_t* src = xc + (tokbase + sp * 32 + xr) * 1536 + hh * 64 + xh * 32;
#pragma unroll
          for (int i = 0; i < 4; ++i) xraw[sp][i] = *(const uint4*)(src + 8 * i); } }
    __syncthreads();
    { int t = 0;
#pragma unroll
      for (int lt = 0; lt < 8; ++lt)
#pragma unroll
          for (int st = 0; st <= lt; ++st, ++t) {
              if ((t & 7) == w) { f32x4 c = F4ZERO;
#pragma unroll
                  for (int ks = 0; ks < 4; ++ks) c = mfma16(*(const bf16x8*)(Bs + (st * 16 + lr) * 136 + ks * 32 + g4 * 8), *(const bf16x8*)(Cs + (lt * 16 + lr) * 136 + ks * 32 + g4 * 8), c);
                  *(f32x4*)(cbt + (t * 64 + lane) * 4) = c; } } }
    __syncthreads();
    bf16x8 xf[4][4];
    { const int xr = lane >> 1, xh = lane & 1;
#pragma unroll
      for (int sp = 0; sp < 4; ++sp) {
#pragma unroll
          for (int i = 0; i < 4; ++i) { bf16_t* vp = xt + (xh * 32 + 8 * i) * 40 + xr; const uint4 r = xraw[sp][i];
              vp[0] = (bf16_t)(r.x & 0xffffu); vp[40] = (bf16_t)(r.x >> 16); vp[80] = (bf16_t)(r.y & 0xffffu); vp[120] = (bf16_t)(r.y >> 16);
              vp[160] = (bf16_t)(r.z & 0xffffu); vp[200] = (bf16_t)(r.z >> 16); vp[240] = (bf16_t)(r.w & 0xffffu); vp[280] = (bf16_t)(r.w >> 16); }
          __builtin_amdgcn_fence(__ATOMIC_RELEASE, "wavefront"); __builtin_amdgcn_wave_barrier(); __builtin_amdgcn_fence(__ATOMIC_ACQUIRE, "wavefront");
#pragma unroll
          for (int pt = 0; pt < 4; ++pt) { const bf16_t* vp = xt + (pt * 16 + lr) * 40 + 4 * g4; xf[sp][pt] = cat4(*(const bf16x4*)vp, *(const bf16x4*)(vp + 16)); }
          __builtin_amdgcn_fence(__ATOMIC_RELEASE, "wavefront"); __builtin_amdgcn_wave_barrier(); __builtin_amdgcn_fence(__ATOMIC_ACQUIRE, "wavefront");
      } }
    const float dsk = p.d_skip[layer * 16 + hh];
    const float* dth = dts + w * 128; const float* ach = acs + w * 128;
    uint2 zn[4];
#pragma unroll
    for (int pt = 0; pt < 4; ++pt) zn[pt] = *(const uint2*)(proj + (tokbase + lr) * LDP + hh * 64 + pt * 16 + 4 * g4);
#pragma unroll
    for (int lt = 0; lt < 8; ++lt) {
        const int l = lt * 16 + lr; const size_t tok = tokbase + l;
        uint2 zr[4];
#pragma unroll
        for (int pt = 0; pt < 4; ++pt) zr[pt] = zn[pt];
        if (lt < 7) {
#pragma unroll
            for (int pt = 0; pt < 4; ++pt) zn[pt] = *(const uint2*)(proj + (tok + 16) * LDP + hh * 64 + pt * 16 + 4 * g4); }
        bf16x8 cf[4];
#pragma unroll
        for (int ks = 0; ks < 4; ++ks) cf[ks] = *(const bf16x8*)(Cs + l * 136 + ks * 32 + g4 * 8);
        const float al = ach[l];
        f32x4 acc[4] = {F4ZERO, F4ZERO, F4ZERO, F4ZERO};
#pragma unroll
        for (int sp = 0; sp <= lt / 2; ++sp) {
            float m[8];
#pragma unroll
            for (int half = 0; half < 2; ++half) { const int T = 2 * sp + half;
                f32x4 cv = F4ZERO; if (T <= lt) cv = *(const f32x4*)(cbt + ((lt * (lt + 1) / 2 + T) * 64 + lane) * 4);
                const float4 dv = *(const float4*)(dth + T * 16 + 4 * g4);
                const float dd[4] = {dv.x, dv.y, dv.z, dv.w};
#pragma unroll
                for (int q = 0; q < 4; ++q) { float mv;
                    if (T < lt) mv = cv[q] * __builtin_amdgcn_exp2f(al + dd[q]);
                    else if (T == lt) { const int s = T * 16 + 4 * g4 + q; mv = (s <= l) ? cv[q] * __builtin_amdgcn_exp2f(al + dd[q]) : 0.f; if (s == l) mv += dsk; }
                    else mv = 0.f;
                    m[half * 4 + q] = mv; } }
            const bf16x8 pf = as_bf8(pack8u(m));
#pragma unroll
            for (int pt = 0; pt < 4; ++pt) acc[pt] = mfma16(xf[sp][pt], pf, acc[pt]);
        }
        f32x4 off[4] = {F4ZERO, F4ZERO, F4ZERO, F4ZERO};
#pragma unroll
        for (int ks = 0; ks < 4; ++ks)
#pragma unroll
            for (int pt = 0; pt < 4; ++pt) off[pt] = mfma16(pv[ks][pt], cf[ks], off[pt]);
        const float ea = __builtin_amdgcn_exp2f(al);
        float ssq = 0.f;
#pragma unroll
        for (int pt = 0; pt < 4; ++pt) { const int col = hh * 64 + pt * 16 + 4 * g4;
            float z[4]; unpack4(zr[pt], z);
            float yv[4];
#pragma unroll
            for (int q = 0; q < 4; ++q) { yv[q] = (acc[pt][q] + off[pt][q] * ea) * silu_f(z[q]); ssq += yv[q] * yv[q]; }
            *(uint2*)(y + tok * DM + col) = pack4u(yv[0], yv[1], yv[2], yv[3]); }
        ssq += __shfl_xor(ssq, 16); ssq += __shfl_xor(ssq, 32);
        if (g4 == 0) ssqp[w * 128 + l] = ssq;
    }
    __syncthreads();
    const float* nw = p.ssd_norm + layer * 1024;
#pragma unroll 4
    for (int lt = 0; lt < 8; ++lt) {
        const int l = lt * 16 + lr; const size_t tok = tokbase + l;
        float tot = 0.f;
#pragma unroll
        for (int k = 0; k < 8; ++k) tot += ssqp[k * 128 + l];
        const float scale = rsqrtf(tot * (1.0f / 512.0f) + 1e-6f);
#pragma unroll
        for (int pt = 0; pt < 4; ++pt) { const int col = hh * 64 + pt * 16 + 4 * g4;
            float yv[4]; unpack4(*(const uint2*)(y + tok * DM + col), yv); const float4 nv = *(const float4*)(nw + col);
            *(uint2*)(y + tok * DM + col) = pack4u(yv[0] * scale * nv.x, yv[1] * scale * nv.y, yv[2] * scale * nv.z, yv[3] * scale * nv.w); }
    }
    __syncthreads();
}

__device__ __forceinline__ void ret_out_item(const Params& p, int layer, int idx, unsigned char* shm) {
    int tid0_ = threadIdx.x; asm volatile("" : "+v"(tid0_)); const int tid = tid0_, lane = tid & 63, w = __builtin_amdgcn_readfirstlane(tid >> 6), lr = lane & 15, g4 = lane >> 4;
    const int h = idx & 3, bc = idx >> 2;
    const size_t tokbase = (size_t)bc * 128;
    bf16_t* Qs = (bf16_t*)shm; bf16_t* Ks = Qs + 128 * 72; bf16_t* Vt = Ks + 128 * 72; bf16_t* Pt = Vt + 128 * 136;
    const bf16_t* proj = (const bf16_t*)(p.ws + OFF_PROJ);
    const float lg2 = log1pf(-exp2f(-5.0f - (float)h)) * 1.4426950408889634f;
    uint2 gr[8];
#pragma unroll
    for (int et = 0; et < 8; ++et) gr[et] = *(const uint2*)(proj + (tokbase + w * 16 + lr) * LDP + PRG + h * 128 + et * 16 + 4 * g4);
    stage_nat<64>(proj + PRQ + h * 64, LDP, tokbase, Qs, 72, tid);
    stage_nat<64>(proj + PRK + h * 64, LDP, tokbase, Ks, 72, tid);
    stage_tr<128>(proj + PRV + h * 128, LDP, tokbase, Vt, 136, nullptr, tid);
    { const float* src = (const float*)(p.ws + OFF_RST) + ((size_t)bc * 4 + h) * 8192 + (tid >> 2) * 64 + (tid & 3) * 16;
      float v[16];
#pragma unroll
      for (int q = 0; q < 4; ++q) { const float4 f = *(const float4*)(src + 4 * q); v[4 * q] = f.x; v[4 * q + 1] = f.y; v[4 * q + 2] = f.z; v[4 * q + 3] = f.w; }
      bf16_t* dp = Pt + (tid >> 2) * 72 + (tid & 3) * 16;
      *(uint4*)dp = pack8u(v); *(uint4*)(dp + 8) = pack8u(v + 8); }
    __syncthreads();
    const int l = w * 16 + lr;
    bf16x8 qf[2];
#pragma unroll
    for (int ks = 0; ks < 2; ++ks) qf[ks] = *(const bf16x8*)(Qs + l * 72 + ks * 32 + g4 * 8);
    f32x4 o[8], cr[8];
#pragma unroll
    for (int et = 0; et < 8; ++et) { o[et] = F4ZERO; cr[et] = F4ZERO; }
#pragma unroll
    for (int sp = 0; sp < 4; ++sp) {
        if (2 * sp <= w) {
            float m[8];
#pragma unroll
            for (int half = 0; half < 2; ++half) { const int T = 2 * sp + half; f32x4 sc = F4ZERO;
                if (T <= w) {
#pragma unroll
                    for (int ks = 0; ks < 2; ++ks) sc = mfma16(*(const bf16x8*)(Ks + (T * 16 + lr) * 72 + ks * 32 + g4 * 8), qf[ks], sc); }
#pragma unroll
                for (int q = 0; q < 4; ++q) { const int s = T * 16 + 4 * g4 + q; const float e = sc[q] * __builtin_amdgcn_exp2f((float)(l - s) * lg2); m[half * 4 + q] = (T < w) ? e : ((s <= l) ? e : 0.f); } }
            const bf16x8 pf = as_bf8(pack8u(m));
#pragma unroll
            for (int et = 0; et < 8; ++et) { const bf16_t* vp = Vt + (et * 16 + lr) * 136 + (2 * sp) * 16 + 4 * g4;
                o[et] = mfma16(cat4(*(const bf16x4*)vp, *(const bf16x4*)(vp + 16)), pf, o[et]); }
        }
    }
#pragma unroll
    for (int ks = 0; ks < 2; ++ks)
#pragma unroll
        for (int et = 0; et < 8; ++et) cr[et] = mfma16(*(const bf16x8*)(Pt + (et * 16 + lr) * 72 + ks * 32 + g4 * 8), qf[ks], cr[et]);
    const float gl = __builtin_amdgcn_exp2f((float)(l + 1) * lg2);
    float ssq = 0.f;
#pragma unroll
    for (int et = 0; et < 8; ++et)
#pragma unroll
        for (int q = 0; q < 4; ++q) { o[et][q] += cr[et][q] * gl; ssq += o[et][q] * o[et][q]; }
    ssq += __shfl_xor(ssq, 16); ssq += __shfl_xor(ssq, 32);
    const float scale = rsqrtf(ssq * (1.0f / 128.0f) + 1e-6f);
    const size_t tok = tokbase + l;
    const float* nw = p.ret_norm + layer * 512;
    bf16_t* y = (bf16_t*)(p.ws + OFF_Y);
#pragma unroll
    for (int et = 0; et < 8; ++et) { const int col = h * 128 + et * 16 + 4 * g4;
        float gt[4]; unpack4(gr[et], gt); const float4 nv = *(const float4*)(nw + col);
        *(uint2*)(y + tok * DM + 1536 + col) = pack4u(o[et][0] * scale * nv.x * silu_f(gt[0]), o[et][1] * scale * nv.y * silu_f(gt[1]), o[et][2] * scale * nv.z * silu_f(gt[2]), o[et][3] * scale * nv.w * silu_f(gt[3])); }
    __syncthreads();
}

#define KA __attribute__((address_space(4)))
__device__ __forceinline__ Params ld_params() {
    const KA Params* pp = (const KA Params*)__builtin_amdgcn_kernarg_segment_ptr();
    asm volatile("" : "+s"(pp));
    Params q; q.x = pp->x; q.ln_mix = pp->ln_mix; q.w_in = pp->w_in; q.conv_w = pp->conv_w; q.conv_b = pp->conv_b; q.dt_bias = pp->dt_bias; q.a_log = pp->a_log; q.d_skip = pp->d_skip; q.ssd_norm = pp->ssd_norm;
    q.q_norm = pp->q_norm; q.k_norm = pp->k_norm; q.ret_norm = pp->ret_norm; q.w_out = pp->w_out; q.ln_ffn = pp->ln_ffn; q.w_gate = pp->w_gate; q.w_up = pp->w_up; q.w_down = pp->w_down; q.out = pp->out; q.ws = pp->ws;
    return q;
}
#ifndef PROBE_MASK
#define PROBE_MASK 0
#endif
#ifndef PROBE_K
#define PROBE_K 2
#endif
#define TICK(id) do { if (PROBE_MASK & (1 << (id))) pt0 = __builtin_amdgcn_s_memrealtime(); } while (0)
#define TOCK(id) do { if (PROBE_MASK & (1 << (id))) pacc += __builtin_amdgcn_s_memrealtime() - pt0; } while (0)
__global__ __launch_bounds__(512, 2) void hybrid_fwd(Params p_unused) {
    extern __shared__ __attribute__((aligned(16))) unsigned char shm[];
    cg::grid_group grid = cg::this_grid();
    unsigned long long pt0 = 0, pacc = 0; (void)pt0;
    volatile XLAS unsigned* bst = (volatile XLAS unsigned*)(shm + 131072);
    if (threadIdx.x == 0) { bst[0] = 0u; bst[1] = 0u; }
    __syncthreads();
    const XcdBarrier xb = xcd_barrier_post((unsigned*)(ld_params().ws + OFF_BAR), bst);
    if (threadIdx.x == 0) bst[2] = xb_add((unsigned*)(ld_params().ws + OFF_BAR) + 16 + xb.x, 1u);
#define GSYNC() xcd_barrier(xb)
    if ((PROBE_MASK & (1 << 13)) && threadIdx.x == 0 && xb.x != (blockIdx.x & 7u)) atomicAdd((unsigned*)(ld_params().ws + OFF_BAR), 1u);
    { const Params p = ld_params(); phase_prep(p, shm); }
    { const Params p = ld_params(); phase_resid<true, true>(p.x, (bf16_t*)(p.ws + OFF_HN), nullptr, (bf16_t*)(p.ws + OFF_Y), p.ln_mix, p.w_in, p.dt_bias, (float*)(p.ws + OFF_DT), shm); }
    grid.sync();
    if (threadIdx.x == 0) { unsigned* bar = (unsigned*)(ld_params().ws + OFF_BAR); bool uni = (gridDim.x & 7u) == 0u;
        for (unsigned j = 0; j < 16; ++j) { const unsigned c = xb_ld(&bar[XB_XCNT(j)]); uni = uni && (c == (j < 8 ? gridDim.x / 8u : 0u)); }
        bst[3] = uni ? (bst[2] * 8u + xb.x) : blockIdx.x; }
    __syncthreads();
    const int vb = (int)bst[3];
    if ((PROBE_MASK & (1 << 14)) && threadIdx.x == 0 && vb != (int)blockIdx.x) atomicAdd((unsigned*)(ld_params().ws + OFF_BAR) + 1, 1u);
#pragma unroll 1
    for (int layer = 0; layer < 2; ++layer) {
        if (layer > 0) {
            TICK(1);
            { const Params p = ld_params(); phase_resid<true, false>(nullptr, (bf16_t*)(p.ws + OFF_HN), nullptr, (bf16_t*)(p.ws + OFF_Y), p.ln_mix + layer * DM, p.w_in + (size_t)layer * DM * INW, p.dt_bias + layer * 16, (float*)(p.ws + OFF_DT), shm); }
            GSYNC();
            TOCK(1);
        }
        TICK(2);
        { const Params p = ld_params(); pg8::EpiProj E; E.O = (bf16_t*)(p.ws + OFF_PROJ); E.ldc = LDP; E.rs = nullptr; run_gemm(shm, (const bf16_t*)(p.ws + OFF_Y), (const bf16_t*)(p.ws + OFF_WIN + layer * SZ_WIN), NTOK, 5632, DM, E, vb); }
        GSYNC();
        TOCK(2);
        TICK(3);
        { const Params p = ld_params(); phase_pre(p, layer); }
        GSYNC();
        TOCK(3);
        TICK(4);
        { const Params p = ld_params(); const int per = (6144 + (int)gridDim.x - 1) / (int)gridDim.x, u0 = (int)blockIdx.x * per; int cnt = 6144 - u0; cnt = cnt < per ? cnt : per;
          att_run(p, u0, cnt, shm); }
        { const Params p = ld_params();
          for (int it = blockIdx.x; it < 1536; it += gridDim.x) {
            if (it < 512) ssd_state_item(p, layer, it, shm);
            else ret_state_item(p, it - 512, shm);
          } }
        GSYNC();
        TOCK(4);
        TICK(5);
        { const Params p = ld_params(); phase_scan(p); }
        GSYNC();
        TOCK(5);
        TICK(6);
        { const Params p = ld_params();
          for (int it = blockIdx.x; it < 1536; it += gridDim.x) {
            if (it < 512) { for (int rep = 0; rep < REP_SO; ++rep) SSD_OUT(p, layer, it, shm); }
            else { for (int rep = 0; rep < REP_RO; ++rep) ret_out_item(p, layer, it - 512, shm); }
          } }
        GSYNC();
        TOCK(6);
        TICK(7);
        { const Params p = ld_params(); pg8::EpiAccB E; E.X = (bf16_t*)(p.ws + OFF_HN); E.ldc = DM; run_gemm(shm, (const bf16_t*)(p.ws + OFF_Y), (const bf16_t*)(p.ws + OFF_WOUT + layer * SZ_WOUT), NTOK, DM, DM, E, vb); }
        GSYNC();
        TOCK(7);
        TICK(8);
        { const Params p = ld_params();
          phase_resid<false, false>(nullptr, (bf16_t*)(p.ws + OFF_HN), nullptr, (bf16_t*)(p.ws + OFF_Y), nullptr, nullptr, nullptr, nullptr, shm); }
        GSYNC();
        TOCK(8);
        TICK(9);
        unsigned long long pc0 = 0, pr0 = 0; if (PROBE_MASK & (1 << 15)) { pc0 = clock64(); pr0 = __builtin_amdgcn_s_memrealtime(); }
        { const Params p = ld_params(); pg8::EpiSwiGLU E; E.H = (bf16_t*)(p.ws + OFF_PROJ); E.ldc = DFF; E.rs = nullptr; run_gemm(shm, (const bf16_t*)(p.ws + OFF_Y), (const bf16_t*)(p.ws + OFF_WGU + layer * SZ_WGU), NTOK, 2 * DFF, DM, E, vb, &pacc); }
        if (PROBE_MASK & (1 << 15)) { const unsigned long long dc = clock64() - pc0, dr = __builtin_amdgcn_s_memrealtime() - pr0; pacc = (layer == 1) ? (dc * 100ull / dr) * 50ull : 0ull; }
        GSYNC();
        TOCK(9);
        TICK(10);
        if (layer == 0) { const Params p = ld_params(); pg8::EpiAccB E; E.X = (bf16_t*)(p.ws + OFF_HN); E.ldc = DM; run_gemm(shm, (const bf16_t*)(p.ws + OFF_PROJ), (const bf16_t*)(p.ws + OFF_WDN + layer * SZ_WDN), NTOK, DM, DFF, E, vb); GSYNC(); }
        else { const Params p = ld_params(); pg8::EpiRes E; E.C = p.out; E.R = (const bf16_t*)(p.ws + OFF_HN); E.ldc = DM; run_gemm(shm, (const bf16_t*)(p.ws + OFF_PROJ), (const bf16_t*)(p.ws + OFF_WDN + layer * SZ_WDN), NTOK, DM, DFF, E, vb); }
        TOCK(10);
    }
    if ((PROBE_MASK & (1 << 13)) && blockIdx.x == 0 && threadIdx.x == 0) pacc = 1000ull * __hip_atomic_load((unsigned*)(ld_params().ws + OFF_BAR), __ATOMIC_RELAXED, __HIP_MEMORY_SCOPE_AGENT);
    if ((PROBE_MASK & (1 << 14)) && blockIdx.x == 0 && threadIdx.x == 0) pacc = 1000ull * __hip_atomic_load((unsigned*)(ld_params().ws + OFF_BAR) + 1, __ATOMIC_RELAXED, __HIP_MEMORY_SCOPE_AGENT);
    if (PROBE_MASK && blockIdx.x == 0 && threadIdx.x == 0) { const unsigned long long ts = __builtin_amdgcn_s_memrealtime(); while (__builtin_amdgcn_s_memrealtime() - ts < (unsigned long long)PROBE_K * pacc) __builtin_amdgcn_s_sleep(8); }
}

extern "C" void kernel_launch(void* const* d_in, const int* in_sizes, int n_in, void* d_out, int out_size, void* d_ws, size_t ws_size, hipStream_t stream) {
    static int grid = 0;
    if (grid == 0) {
        if (n_in != 17 || ws_size < WS_END) { fprintf(stderr, "kernel_launch: unexpected n_in %d / ws_size %zu (need %zu)\n", n_in, ws_size, (size_t)WS_END); grid = -1; return; }
        int dev = 0, cus = 0, per_cu = 0;
        (void)hipGetDevice(&dev); (void)hipDeviceGetAttribute(&cus, hipDeviceAttributeMultiprocessorCount, dev);
        if (hipFuncSetAttribute((const void*)hybrid_fwd, hipFuncAttributeMaxDynamicSharedMemorySize, LDS_BYTES) != hipSuccess) { fprintf(stderr, "kernel_launch: hipFuncSetAttribute failed\n"); grid = -1; return; }
        if (hipOccupancyMaxActiveBlocksPerMultiprocessor(&per_cu, (const void*)hybrid_fwd, 512, LDS_BYTES) != hipSuccess || per_cu < 1) { fprintf(stderr, "kernel_launch: occupancy query says %d\n", per_cu); per_cu = 1; }
        (void)hipGetLastError();
        grid = cus * per_cu;
    }
    if (grid < 0) return;
    Params p{};
    const float** f = (const float**)&p;
    for (int i = 0; i < 17; ++i) f[i] = (const float*)d_in[i];
    p.out = (float*)d_out; p.ws = (unsigned char*)d_ws;
    if (hipMemsetAsync((unsigned char*)d_ws + OFF_BAR, 0, (size_t)XCD_BAR_WORDS * 4, stream) != hipSuccess) { fprintf(stderr, "kernel_launch: memset of the barrier words failed\n"); return; }
    void* args[] = {&p};
    const hipError_t e = hipLaunchCooperativeKernel((const void*)hybrid_fwd, dim3(grid), dim3(512), args, LDS_BYTES, stream);
    if (e != hipSuccess) fprintf(stderr, "kernel_launch: cooperative launch failed: %s (grid %d)\n", hipGetErrorString(e), grid);
}
```

```cpp
#include <hip/hip_runtime.h>
#include <hip/hip_cooperative_groups.h>
#include <cstdio>
namespace cg = cooperative_groups;
#ifndef PROBE_MASK
#define PROBE_MASK 0
#endif
#ifndef PROBE_K
#define PROBE_K 2
#endif
#ifndef PROBE_GEMM
#define PROBE_GEMM 9
#endif
#ifndef REP_SO
#define REP_SO 1
#endif
#ifndef REP_RO
#define REP_RO 1
#endif
#ifndef SSD_OUT
#define SSD_OUT ssd_out_item2
#endif
#include <cstdint>
#define XB_TMO      128
#define XB_XCNT(j)  (256  + 64 * (j))
#define XB_XSUB(j)  (1280 + 64 * (j))
#define XB_XGEN(j)  (2304 + 64 * (j))
#define XB_TOP      3328
#define XB_TOPGEN   3392
#define XCD_BAR_WORDS 3456
#define XB_SPIN_CAP (1u << 18)
#define XLAS __attribute__((address_space(3)))

__device__ __forceinline__ unsigned xb_ld(unsigned* p)              { return __hip_atomic_load(p, __ATOMIC_RELAXED, __HIP_MEMORY_SCOPE_AGENT); }
__device__ __forceinline__ unsigned xb_add(unsigned* p, unsigned v) { return __hip_atomic_fetch_add(p, v, __ATOMIC_RELAXED, __HIP_MEMORY_SCOPE_AGENT); }
__device__ __forceinline__ unsigned xb_xcc_id() { return (unsigned)__builtin_amdgcn_s_getreg((3 << 11) | 20) & 0xFu; }
#define XB_SPIN(cond, bar) do { unsigned _sp = 0; while (cond) { __builtin_amdgcn_s_sleep(1); \
    if ((++_sp & 255u) == 0u) { if (xb_ld(&(bar)[XB_TMO])) break; if (_sp > XB_SPIN_CAP) { atomicAdd(&(bar)[XB_TMO], 1u); break; } } } } while (0)

struct XcdBarrier {
    unsigned* bar; unsigned x;
    volatile XLAS unsigned* st;
};

__device__ __forceinline__ XcdBarrier xcd_barrier_post(unsigned* bar, volatile XLAS unsigned* st) {
    XcdBarrier b; b.bar = bar; b.x = xb_xcc_id(); b.st = st;
    if (threadIdx.x == 0) (void)xb_add(&bar[XB_XCNT(b.x)], 1u);
    return b;
}
__device__ __forceinline__ void xcd_barrier_complete(unsigned* bar, unsigned x, unsigned& nloc, unsigned& nx) {
    const unsigned G = gridDim.x * gridDim.y * gridDim.z;
    unsigned sum, cnt, mine, sp = 0u;
    for (;;) {
        sum = 0u; cnt = 0u; mine = 0u;
#pragma unroll
        for (unsigned j = 0; j < 16; ++j) { const unsigned c = xb_ld(&bar[XB_XCNT(j)]); sum += c; cnt += (c > 0u) ? 1u : 0u; mine = (j == x) ? c : mine; }
        if (sum == G) break;
        __builtin_amdgcn_s_sleep(1);
        if ((++sp & 255u) == 0u) { if (xb_ld(&bar[XB_TMO])) break; if (sp > XB_SPIN_CAP) { atomicAdd(&bar[XB_TMO], 1u); break; } }
    }
    nloc = mine > 0u ? mine : 1u; nx = cnt > 0u ? cnt : 1u;
}

__device__ __forceinline__ void xcd_barrier(const XcdBarrier& b) {
    asm volatile("s_waitcnt vmcnt(0)" ::: "memory");
    __syncthreads();
    if (threadIdx.x == 0) {
        unsigned* bar = b.bar;
        __builtin_amdgcn_s_waitcnt(0);
        unsigned nloc = b.st[0], nx = b.st[1];
        if (nloc == 0u) { xcd_barrier_complete(bar, b.x, nloc, nx); b.st[0] = nloc; b.st[1] = nx; }
        const unsigned old = xb_add(&bar[XB_XSUB(b.x)], 1u);
        const unsigned gen = old / nloc;
        if (old + 1u == (gen + 1u) * nloc) {
            __builtin_amdgcn_fence(__ATOMIC_RELEASE, "agent");
            asm volatile("s_waitcnt vmcnt(0)" ::: "memory");
            const unsigned og = xb_add(&bar[XB_TOP], 1u);
            const unsigned tg = og / nx;
            if (og + 1u == (tg + 1u) * nx) xb_add(&bar[XB_TOPGEN], 1u);
            else XB_SPIN(xb_ld(&bar[XB_TOPGEN]) == tg, bar);
            __builtin_amdgcn_fence(__ATOMIC_ACQUIRE, "agent");
            xb_add(&bar[XB_XGEN(b.x)], 1u);
            asm volatile("s_waitcnt vmcnt(0)" ::: "memory");
        } else {
            XB_SPIN(xb_ld(&bar[XB_XGEN(b.x)]) == gen, bar);
            __builtin_amdgcn_fence(__ATOMIC_ACQUIRE, "agent");
            asm volatile("s_waitcnt vmcnt(0)" ::: "memory");
        }
    }
    __syncthreads();
}

namespace pg8 {
#define PG8_LAS __attribute__((address_space(3)))
typedef unsigned short bf16_t;
typedef short bf16x8 __attribute__((ext_vector_type(8)));
typedef float f32x4 __attribute__((ext_vector_type(4)));
typedef unsigned u32x4 __attribute__((ext_vector_type(4)));
constexpr int BM = 256, BK = 64, HALF = 128, HTB = HALF * BK * 2  , STAGE_BYTES = 8 * HTB, NXCD = 8, WGM = 8;

__host__ __device__ __forceinline__ int lds_byte(int r, int c) { const int st = (r >> 4) * 2 + (c >> 5), rr = r & 15, cc = c & 31, ob = rr * 64 + cc * 2; return st * 1024 + (ob ^ (((ob >> 9) & 1) << 5)); }
__host__ __device__ __forceinline__ void stage_rc(int b, int& R, int& C) { const int st = b / 1024, sb = b % 1024, swz = sb ^ (((sb >> 9) & 1) << 5); R = (st >> 1) * 16 + swz / 64; C = (st & 1) * 32 + (swz % 64) / 2; }
__host__ __device__ __forceinline__ int perm32(int rho) { const int n = rho >> 4, i = rho & 15; return 8 * (i >> 2) + 4 * n + (i & 3); }

struct Unit { int pm, pn; };
struct Gemm { const bf16_t* A; const bf16_t* Bt; int M, N, K; };

struct StaticOrder {
    int nM, nN, nwg, G, c;
    __host__ __device__ void init(int M, int N, int G_, int c_) { nM = M / BM; nN = N / BM; nwg = nM * nN; G = G_; c = c_; }
    __host__ __device__ bool next(int i, Unit& u) const {
        const long L = (long)i * G + c; if (L >= nwg) return false;
        int wgid = (int)L; { const int q = nwg / NXCD, r = nwg % NXCD, xcd = wgid % NXCD, off = wgid / NXCD; wgid = (xcd < r ? xcd * (q + 1) : r * (q + 1) + (xcd - r) * q) + off; }
        const int nig = WGM * nN, gid = wgid / nig, fm = gid * WGM, gsz = (nM - fm) < WGM ? (nM - fm) : WGM;
        u.pm = fm + ((wgid % nig) % gsz); u.pn = (wgid % nig) / gsz; return true;
    }
    __device__ __forceinline__ void a_ready(const Unit&) const {}
    __device__ __forceinline__ void done(const Unit&) const {}
};
__device__ __forceinline__ unsigned cvt_pk_bf16(float lo, float hi) { unsigned r; asm volatile("v_cvt_pk_bf16_f32 %0, %1, %2" : "=v"(r) : "v"(lo), "v"(hi)); return r; }
struct EpiProj {
    static constexpr bool PERM = true, AFTER_DRAIN = false;
    bf16_t* O; int ldc; const float* rs;
    __device__ __forceinline__ void operator()(const f32x4 (&acc)[2][2][4][2], const Unit& u, int wr, int wc, int fr, int fq) const {
        const int row0 = u.pm * BM + wr * 64 + fr, col0 = u.pn * BM + wc * 32 + 8 * fq;
#pragma unroll
        for (int ai = 0; ai < 2; ++ai)
#pragma unroll
            for (int m = 0; m < 4; ++m) { bf16_t* rowp = O + (size_t)(row0 + ai * HALF + m * 16) * ldc + col0; const float sc = rs ? rs[row0 + ai * HALF + m * 16] : 1.0f;
#pragma unroll
                for (int bj = 0; bj < 2; ++bj) { const f32x4 v0 = acc[ai][bj][m][0] * sc, v1 = acc[ai][bj][m][1] * sc;
                    u32x4 w; w.x = cvt_pk_bf16(v0[0], v0[1]); w.y = cvt_pk_bf16(v0[2], v0[3]); w.z = cvt_pk_bf16(v1[0], v1[1]); w.w = cvt_pk_bf16(v1[2], v1[3]);
                    *(u32x4*)(rowp + bj * HALF) = w; } }
    }
};
struct EpiRes {
    static constexpr bool PERM = false, AFTER_DRAIN = false;
    float* C; const bf16_t* R; int ldc;
    __device__ __forceinline__ void operator()(const f32x4 (&acc)[2][2][4][2], const Unit& u, int wr, int wc, int fr, int fq) const {
        const int row0 = u.pm * BM + wr * 64 + fr, col0 = u.pn * BM + wc * 32 + 4 * fq;
#pragma unroll
        for (int ai = 0; ai < 2; ++ai)
#pragma unroll
            for (int m = 0; m < 4; ++m) { const size_t ro = (size_t)(row0 + ai * HALF + m * 16) * ldc + col0;
#pragma unroll
                for (int bj = 0; bj < 2; ++bj)
#pragma unroll
                    for (int n = 0; n < 2; ++n) { const uint2 rw = *(const uint2*)(R + ro + bj * HALF + n * 16);
                        f32x4 r; r[0] = __uint_as_float(rw.x << 16); r[1] = __uint_as_float(rw.x & 0xffff0000u); r[2] = __uint_as_float(rw.y << 16); r[3] = __uint_as_float(rw.y & 0xffff0000u);
                        *(f32x4*)(C + ro + bj * HALF + n * 16) = acc[ai][bj][m][n] + r; } }
    }
};
__device__ __forceinline__ float silu_f(float v) { return v * __builtin_amdgcn_rcpf(1.0f + __expf(-v)); }
struct EpiSwiGLU {
    static constexpr bool PERM = true, AFTER_DRAIN = false;
    bf16_t* H; int ldc; const float* rs;
    __device__ __forceinline__ void operator()(const f32x4 (&acc)[2][2][4][2], const Unit& u, int wr, int wc, int fr, int fq) const {
        const int row0 = u.pm * BM + wr * 64 + fr, col0 = u.pn * HALF + wc * 32 + 8 * fq;
#pragma unroll
        for (int ai = 0; ai < 2; ++ai)
#pragma unroll
            for (int m = 0; m < 4; ++m) { bf16_t* rowp = H + (size_t)(row0 + ai * HALF + m * 16) * ldc + col0; const float sc = rs ? rs[row0 + ai * HALF + m * 16] : 1.0f;
                f32x4 v0, v1;
#pragma unroll
                for (int j = 0; j < 4; ++j) { v0[j] = silu_f(acc[ai][0][m][0][j] * sc) * (acc[ai][1][m][0][j] * sc); v1[j] = silu_f(acc[ai][0][m][1][j] * sc) * (acc[ai][1][m][1][j] * sc); }
                u32x4 w; w.x = cvt_pk_bf16(v0[0], v0[1]); w.y = cvt_pk_bf16(v0[2], v0[3]); w.z = cvt_pk_bf16(v1[0], v1[1]); w.w = cvt_pk_bf16(v1[2], v1[3]);
                *(u32x4*)rowp = w; }
    }
};
struct EpiAccB {
    static constexpr bool PERM = true, AFTER_DRAIN = false;
    bf16_t* X; int ldc;
    __device__ __forceinline__ void operator()(const f32x4 (&acc)[2][2][4][2], const Unit& u, int wr, int wc, int fr, int fq) const {
        const int row0 = u.pm * BM + wr * 64 + fr, col0 = u.pn * BM + wc * 32 + 8 * fq;
#pragma unroll
        for (int ai = 0; ai < 2; ++ai) {
            u32x4 old[4][2];
#pragma unroll
            for (int m = 0; m < 4; ++m)
#pragma unroll
                for (int bj = 0; bj < 2; ++bj) old[m][bj] = *(const u32x4*)(X + (size_t)(row0 + ai * HALF + m * 16) * ldc + col0 + bj * HALF);
#pragma unroll
            for (int m = 0; m < 4; ++m)
#pragma unroll
                for (int bj = 0; bj < 2; ++bj) { const f32x4 v0 = acc[ai][bj][m][0], v1 = acc[ai][bj][m][1]; const u32x4 o = old[m][bj];
                    u32x4 w;
                    w.x = cvt_pk_bf16(v0[0] + __uint_as_float(o.x << 16), v0[1] + __uint_as_float(o.x & 0xffff0000u)); w.y = cvt_pk_bf16(v0[2] + __uint_as_float(o.y << 16), v0[3] + __uint_as_float(o.y & 0xffff0000u));
                    w.z = cvt_pk_bf16(v1[0] + __uint_as_float(o.z << 16), v1[1] + __uint_as_float(o.z & 0xffff0000u)); w.w = cvt_pk_bf16(v1[2] + __uint_as_float(o.w << 16), v1[3] + __uint_as_float(o.w & 0xffff0000u));
                    *(u32x4*)(X + (size_t)(row0 + ai * HALF + m * 16) * ldc + col0 + bj * HALF) = w; }
        }
    }
};
template <class Epi, class Sched, bool ALIGN_EPI = false, bool SP2 = false>
__device__ __forceinline__ void gemm_phase(PG8_LAS unsigned char* lds, const Gemm g, const Sched& S, const Epi& E) {
    int tid0_ = threadIdx.x; asm volatile("" : "+v"(tid0_)); const int tid = tid0_, wid = __builtin_amdgcn_readfirstlane(tid >> 6), lane = tid & 63, wr = wid >> 2, wc = wid & 3, fr = lane & 15, fq = lane >> 4;
    const int K = g.K, nt = K / BK;
    unsigned voffA[2], voffB[2];
#pragma unroll
    for (int i = 0; i < 2; ++i) { int R, C; stage_rc(tid * 16 + i * 8192, R, C); const int Rb = Epi::PERM ? ((R & ~31) + perm32(R & 31)) : R;
        voffA[i] = (unsigned)(R * K + C) * 2u; voffB[i] = (unsigned)(Rb * K + C) * 2u; }
    const size_t kstep = (size_t)(BK * 2);
    const size_t hstep = (size_t)HALF * K * 2;
    const size_t tstep = 2 * hstep;
    const unsigned ldsw = (unsigned)wid * 1024u;
    const int aoff = lds_byte(wr * 64 + fr, fq * 8), boff = lds_byte(wc * 32 + fr, fq * 8);
#define PG8_SA(b, h) (((b) * 2 + (h)) * HTB)
#define PG8_SB(b, h) ((4 + (b) * 2 + (h)) * HTB)
#define PG8_STAGE(bufoff, gbase, voff) do { _Pragma("unroll") for (int _i = 0; _i < 2; ++_i) \
        __builtin_amdgcn_global_load_lds((const unsigned*)((const char*)(gbase) + (voff)[_i]), (PG8_LAS unsigned*)(lds + (bufoff) + ldsw + _i * 8192), 16, 0, 0); } while (0)
#define PG8_LDA(dst, b, h) do { _Pragma("unroll") for (int m = 0; m < 4; ++m) _Pragma("unroll") for (int k = 0; k < 2; ++k) dst[m][k] = *(const PG8_LAS bf16x8*)(lds + PG8_SA(b, h) + aoff + m * 2048 + k * 1024); } while (0)
#define PG8_LDB(dst, b, h) do { _Pragma("unroll") for (int n = 0; n < 2; ++n) _Pragma("unroll") for (int k = 0; k < 2; ++k) dst[n][k] = *(const PG8_LAS bf16x8*)(lds + PG8_SB(b, h) + boff + n * 2048 + k * 1024); } while (0)
#define PG8_MMA(ai, bj, At, Bt) do { __builtin_amdgcn_s_setprio(1); _Pragma("unroll") for (int m = 0; m < 4; ++m) _Pragma("unroll") for (int n = 0; n < 2; ++n) _Pragma("unroll") for (int k = 0; k < 2; ++k) \
        acc[ai][bj][m][n] = __builtin_amdgcn_mfma_f32_16x16x32_bf16(Bt[n][k], At[m][k], acc[ai][bj][m][n], 0, 0, 0); __builtin_amdgcn_s_setprio(0); } while (0)
#define PG8_WAIT_V(n) asm volatile("s_waitcnt vmcnt(" #n ")" ::: "memory")
#define PG8_WAIT_L(n) asm volatile("s_waitcnt lgkmcnt(" #n ")" ::: "memory")
#define PG8_BAR __builtin_amdgcn_s_barrier()
#define PG8_SCHED __builtin_amdgcn_sched_barrier(0)
    Unit cur, nxt; int ui = 0;
    if (!S.next(0, cur)) return;
    f32x4 acc[2][2][4][2];
#pragma unroll
    for (int a = 0; a < 2; ++a)
#pragma unroll
        for (int b = 0; b < 2; ++b)
#pragma unroll
            for (int m = 0; m < 4; ++m)
#pragma unroll
                for (int n = 0; n < 2; ++n) acc[a][b][m][n] = (f32x4){0.f, 0.f, 0.f, 0.f};
    bf16x8 At[4][2], B0[2][2], B1[2][2];
    const char* cA = (const char*)g.A + (size_t)cur.pm * tstep; const char* cB = (const char*)g.Bt + (size_t)cur.pn * tstep;
    S.a_ready(cur);
    if constexpr (SP2) {
        PG8_STAGE(PG8_SB(0, 0), cB, voffB); PG8_STAGE(PG8_SB(0, 1), cB + hstep, voffB); PG8_STAGE(PG8_SA(0, 0), cA, voffA); PG8_STAGE(PG8_SA(0, 1), cA + hstep, voffA);
        if (wr == 1) PG8_BAR;
        PG8_WAIT_V(2); PG8_BAR;
        PG8_STAGE(PG8_SB(1, 0), cB + kstep, voffB); PG8_STAGE(PG8_SA(1, 0), cA + kstep, voffA); PG8_STAGE(PG8_SB(1, 1), cB + hstep + kstep, voffB);
        PG8_WAIT_V(6); PG8_BAR;
    } else {
        PG8_STAGE(PG8_SB(0, 0), cB, voffB); PG8_STAGE(PG8_SA(0, 0), cA, voffA); PG8_STAGE(PG8_SB(0, 1), cB + hstep, voffB); PG8_STAGE(PG8_SA(0, 1), cA + hstep, voffA);
        if (wr == 1) PG8_BAR;
        PG8_WAIT_V(4); PG8_BAR;
        PG8_STAGE(PG8_SB(1, 0), cB + kstep, voffB); PG8_STAGE(PG8_SA(1, 0), cA + kstep, voffA); PG8_STAGE(PG8_SB(1, 1), cB + hstep + kstep, voffB);
        PG8_WAIT_V(6); PG8_BAR;
    }
    for (;;) {
        const bool has_next = S.next(ui + 1, nxt);
        const char* nA = has_next ? (const char*)g.A + (size_t)nxt.pm * tstep : cA; const char* nB = has_next ? (const char*)g.Bt + (size_t)nxt.pn * tstep : cB;
        for (int t = 0; t < nt; t += 2) {
            const bool last = (t == nt - 2);
            const char* a1 = cA + (size_t)(t + 1) * kstep;
            const char* a2 = last ? nA : cA + (size_t)(t + 2) * kstep; const char* b2 = last ? nB : cB + (size_t)(t + 2) * kstep;
            const char* a3 = a2 + kstep; const char* b3 = b2 + kstep;
            if (last && has_next) S.a_ready(nxt);
            if constexpr (SP2) {
            PG8_LDB(B0, 0, 0); PG8_LDB(B1, 0, 1); PG8_SCHED; PG8_LDA(At, 0, 0); PG8_STAGE(PG8_SA(1, 1), a1 + hstep, voffA);
            PG8_WAIT_V(8); PG8_WAIT_L(0); PG8_BAR; PG8_MMA(0, 0, At, B0); PG8_MMA(0, 1, At, B1); PG8_BAR; PG8_SCHED;
            PG8_LDA(At, 0, 1); PG8_STAGE(PG8_SB(0, 0), b2, voffB); PG8_STAGE(PG8_SB(0, 1), b2 + hstep, voffB); PG8_STAGE(PG8_SA(0, 0), a2, voffA);
            PG8_WAIT_V(8); PG8_WAIT_L(0); PG8_BAR; PG8_MMA(1, 0, At, B0); PG8_MMA(1, 1, At, B1); PG8_BAR; PG8_SCHED;
            PG8_LDB(B0, 1, 0); PG8_LDB(B1, 1, 1); PG8_SCHED; PG8_LDA(At, 1, 0); PG8_STAGE(PG8_SA(0, 1), a2 + hstep, voffA);
            PG8_WAIT_V(8); PG8_WAIT_L(0); PG8_BAR; PG8_MMA(0, 0, At, B0); PG8_MMA(0, 1, At, B1); PG8_BAR; PG8_SCHED;
            PG8_LDA(At, 1, 1); PG8_STAGE(PG8_SB(1, 0), b3, voffB); PG8_STAGE(PG8_SB(1, 1), b3 + hstep, voffB); PG8_STAGE(PG8_SA(1, 0), a3, voffA);
            PG8_WAIT_V(8); PG8_WAIT_L(0); PG8_BAR; PG8_MMA(1, 0, At, B0); PG8_MMA(1, 1, At, B1); PG8_BAR; PG8_SCHED;
            } else {
            PG8_LDB(B0, 0, 0); PG8_SCHED; PG8_LDA(At, 0, 0); PG8_STAGE(PG8_SA(1, 1), a1 + hstep, voffA);
            PG8_WAIT_L(8); PG8_BAR; PG8_WAIT_L(0); PG8_MMA(0, 0, At, B0); PG8_BAR; PG8_SCHED;
            PG8_LDB(B1, 0, 1); PG8_STAGE(PG8_SB(0, 0), b2, voffB);
            PG8_BAR; PG8_WAIT_L(0); PG8_MMA(0, 1, At, B1); PG8_BAR;
            PG8_LDA(At, 0, 1); PG8_STAGE(PG8_SA(0, 0), a2, voffA);
            PG8_BAR; PG8_WAIT_L(0); PG8_MMA(1, 0, At, B0); PG8_BAR; PG8_SCHED;
            PG8_STAGE(PG8_SB(0, 1), b2 + hstep, voffB);
            PG8_WAIT_V(6); PG8_BAR; PG8_MMA(1, 1, At, B1); PG8_BAR;
            PG8_LDB(B0, 1, 0); PG8_SCHED; PG8_LDA(At, 1, 0); PG8_STAGE(PG8_SA(0, 1), a2 + hstep, voffA);
            PG8_WAIT_L(8); PG8_BAR; PG8_WAIT_L(0); PG8_MMA(0, 0, At, B0); PG8_BAR; PG8_SCHED;
            PG8_LDB(B1, 1, 1); PG8_STAGE(PG8_SB(1, 0), b3, voffB);
            PG8_BAR; PG8_WAIT_L(0); PG8_MMA(0, 1, At, B1); PG8_BAR;
            PG8_LDA(At, 1, 1); PG8_STAGE(PG8_SA(1, 0), a3, voffA);
            PG8_BAR; PG8_WAIT_L(0); PG8_MMA(1, 0, At, B0); PG8_BAR; PG8_SCHED;
            PG8_STAGE(PG8_SB(1, 1), b3 + hstep, voffB);
            PG8_WAIT_V(6); PG8_BAR; PG8_MMA(1, 1, At, B1); PG8_BAR;
            }
        }
        if constexpr (ALIGN_EPI) { if (wr == 0) PG8_BAR; }
        if constexpr (!Epi::AFTER_DRAIN) { E(acc, cur, wr, wc, fr, fq); S.done(cur); }
        if (!has_next) break;
#pragma unroll
        for (int a = 0; a < 2; ++a)
#pragma unroll
            for (int b = 0; b < 2; ++b)
#pragma unroll
                for (int m = 0; m < 4; ++m)
#pragma unroll
                    for (int n = 0; n < 2; ++n) acc[a][b][m][n] = (f32x4){0.f, 0.f, 0.f, 0.f};
        cur = nxt; cA = nA; cB = nB; ++ui;
        if constexpr (ALIGN_EPI) { if (wr == 1) PG8_BAR; }
    }
    PG8_WAIT_V(0);
    if constexpr (!ALIGN_EPI) { if (wr == 0) PG8_BAR; }
    PG8_BAR;
    if constexpr (Epi::AFTER_DRAIN) { E.fused(acc, cur, wr, wc, fr, fq, lds, wid, lane); S.done(cur); }
#undef PG8_SA
#undef PG8_SB
#undef PG8_STAGE
#undef PG8_LDA
#undef PG8_LDB
#undef PG8_MMA
#undef PG8_WAIT_V
#undef PG8_WAIT_L
#undef PG8_BAR
#undef PG8_SCHED
}
}

using pg8::bf16_t; using pg8::bf16x8; using pg8::f32x4; using pg8::cvt_pk_bf16; using pg8::silu_f;
typedef short bf16x4 __attribute__((ext_vector_type(4)));

constexpr int NTOK = 32768, DM = 2048, SEQ = 8192, LDP = 5632, DFF = 5632, INW = 5648;
constexpr int PXBC = 1024, PAQ = 2560, PAK = 3072, PAV = 3584, PRQ = 4096, PRK = 4352, PRV = 4608, PRG = 5120;
constexpr int LDS_BYTES = 131072 + 16;

constexpr size_t SZ_WIN = (size_t)5632 * 2048 * 2, SZ_WOUT = (size_t)2048 * 2048 * 2, SZ_WGU = (size_t)11264 * 2048 * 2, SZ_WDN = (size_t)2048 * 5632 * 2;
constexpr size_t OFF_WIN = 0, OFF_WOUT = OFF_WIN + 2 * SZ_WIN, OFF_WGU = OFF_WOUT + 2 * SZ_WOUT, OFF_WDN = OFF_WGU + 2 * SZ_WGU;
constexpr size_t OFF_HN = OFF_WDN + 2 * SZ_WDN;
constexpr size_t OFF_Y = OFF_HN + (size_t)NTOK * DM * 2;
constexpr size_t OFF_PROJ = OFF_Y + (size_t)NTOK * DM * 2;
constexpr size_t OFF_SST = OFF_PROJ + (size_t)NTOK * LDP * 2;
constexpr size_t OFF_RST = OFF_SST + (size_t)4096 * 8192 * 2;
constexpr size_t OFF_LSE = OFF_RST + (size_t)1024 * 8192 * 4;
constexpr size_t OFF_DT = OFF_LSE + (size_t)3 * NTOK * 8 * 4;
constexpr size_t OFF_CDEC = OFF_DT + (size_t)NTOK * 16 * 4;
constexpr size_t OFF_ROPE = OFF_CDEC + (size_t)4096 * 4;
constexpr size_t OFF_XC = OFF_ROPE + (size_t)8192 * 32 * 4 * 2;
constexpr size_t OFF_BAR = OFF_XC + (size_t)NTOK * 1536 * 2;
constexpr size_t OFF_RSTD = OFF_BAR + (size_t)XCD_BAR_WORDS * 4;
constexpr size_t WS_END = OFF_RSTD + (size_t)NTOK * 4;

#ifndef REP_PREP
#define REP_PREP 1
#endif
#ifndef REP_NORM
#define REP_NORM 1
#endif
#ifndef REP_INPROJ
#define REP_INPROJ 1
#endif
#ifndef REP_M1
#define REP_M1 1
#endif
#ifndef REP_ATT
#define REP_ATT 1
#endif
#ifndef REP_ST
#define REP_ST 1
#endif
#ifndef REP_GU
#define REP_GU 1
#endif
#ifndef REP_NORM2
#define REP_NORM2 1
#endif
#ifndef REP_SYNC
#define REP_SYNC 0
#endif
#ifndef REP_M3
#define REP_M3 1
#endif
struct Params {
    const float *x, *ln_mix, *w_in, *conv_w, *conv_b, *dt_bias, *a_log, *d_skip, *ssd_norm, *q_norm, *k_norm, *ret_norm, *w_out, *ln_ffn, *w_gate, *w_up, *w_down;
    float* out;
    unsigned char* ws;
};

__device__ __forceinline__ bf16x8 as_bf8(uint4 v) { return __builtin_bit_cast(bf16x8, v); }
__device__ __forceinline__ bf16x8 cat4(bf16x4 a, bf16x4 b) { return __builtin_shufflevector(a, b, 0, 1, 2, 3, 4, 5, 6, 7); }
__device__ __forceinline__ uint4 pack8u(const float* v) { uint4 w; w.x = cvt_pk_bf16(v[0], v[1]); w.y = cvt_pk_bf16(v[2], v[3]); w.z = cvt_pk_bf16(v[4], v[5]); w.w = cvt_pk_bf16(v[6], v[7]); return w; }
__device__ __forceinline__ uint2 pack4u(float a, float b, float c, float d) { uint2 w; w.x = cvt_pk_bf16(a, b); w.y = cvt_pk_bf16(c, d); return w; }
__device__ __forceinline__ void unpack8(uint4 r, float* v) {
    v[0] = __uint_as_float(r.x << 16); v[1] = __uint_as_float(r.x & 0xffff0000u); v[2] = __uint_as_float(r.y << 16); v[3] = __uint_as_float(r.y & 0xffff0000u);
    v[4] = __uint_as_float(r.z << 16); v[5] = __uint_as_float(r.z & 0xffff0000u); v[6] = __uint_as_float(r.w << 16); v[7] = __uint_as_float(r.w & 0xffff0000u); }
__device__ __forceinline__ void unpack4(uint2 r, float* v) {
    v[0] = __uint_as_float(r.x << 16); v[1] = __uint_as_float(r.x & 0xffff0000u); v[2] = __uint_as_float(r.y << 16); v[3] = __uint_as_float(r.y & 0xffff0000u); }
__device__ __forceinline__ bf16_t f2bf(float f) { return (bf16_t)(cvt_pk_bf16(f, 0.f) & 0xffffu); }
__device__ __forceinline__ f32x4 mfma16(bf16x8 a, bf16x8 b, f32x4 c) { return __builtin_amdgcn_mfma_f32_16x16x32_bf16(a, b, c, 0, 0, 0); }
#define F4ZERO ((f32x4){0.f, 0.f, 0.f, 0.f})

struct WtTile { const float* src; const float* gk; bf16_t* dst; int ld, ldd; };
__device__ __forceinline__ WtTile wt_decode(const Params& p, int id) {
    WtTile T; const int layer = id / 12288; int r = id - layer * 12288;
    if (r < 2816) { const int kt = r / 88, nt = r - kt * 88, n0 = nt * 64;
        T.src = p.w_in + (size_t)layer * DM * INW + (size_t)(kt * 64) * INW + (n0 < 2560 ? n0 : n0 + 16); T.ld = INW; T.dst = (bf16_t*)(p.ws + OFF_WIN + layer * SZ_WIN) + (size_t)n0 * DM + kt * 64; T.ldd = DM; T.gk = p.ln_mix + layer * DM + kt * 64; }
    else if ((r -= 2816) < 1024) { const int kt = r >> 5, nt = r & 31;
        T.src = p.w_out + (size_t)layer * DM * DM + (size_t)(kt * 64) * DM + nt * 64; T.ld = DM; T.dst = (bf16_t*)(p.ws + OFF_WOUT + layer * SZ_WOUT) + (size_t)(nt * 64) * DM + kt * 64; T.ldd = DM; T.gk = nullptr; }
    else if ((r -= 1024) < 5632) { const int kt = r / 176, nt = r - kt * 176, n0 = nt * 64, pn = n0 >> 8, bj = (n0 >> 7) & 1, j0 = n0 & 127;
        T.src = (bj ? p.w_up : p.w_gate) + (size_t)layer * DM * DFF + (size_t)(kt * 64) * DFF + pn * 128 + j0; T.ld = DFF; T.dst = (bf16_t*)(p.ws + OFF_WGU + layer * SZ_WGU) + (size_t)n0 * DM + kt * 64; T.ldd = DM; T.gk = p.ln_ffn + layer * DM + kt * 64; }
    else { r -= 5632; const int kt = r >> 5, nt = r & 31;
        T.src = p.w_down + (size_t)layer * DFF * DM + (size_t)(kt * 64) * DM + nt * 64; T.ld = DM; T.dst = (bf16_t*)(p.ws + OFF_WDN + layer * SZ_WDN) + (size_t)(nt * 64) * DFF + kt * 64; T.ldd = DFF; T.gk = nullptr; }
    return T;
}
__device__ __forceinline__ void phase_prep(const Params& p, unsigned char* shm) {
    float* t = (float*)shm;
    int tid0_ = threadIdx.x; asm volatile("" : "+v"(tid0_)); const int tid = tid0_, nn = tid & 63, kk0 = tid >> 6;
    const int NT = 2 * 12288;
    int id = blockIdx.x;
    float r0, r1, r2, r3, r4, r5, r6, r7; r0 = r1 = r2 = r3 = r4 = r5 = r6 = r7 = 0.f;
    WtTile T; T.src = nullptr; T.gk = nullptr; T.dst = nullptr; T.ld = 0; T.ldd = 0;
#define WT_LOAD(TT) do { const float* s_ = (TT).src + (size_t)kk0 * (TT).ld + nn; const size_t st_ = (size_t)8 * (TT).ld; \
        r0 = s_[0]; r1 = s_[st_]; r2 = s_[2 * st_]; r3 = s_[3 * st_]; r4 = s_[4 * st_]; r5 = s_[5 * st_]; r6 = s_[6 * st_]; r7 = s_[7 * st_]; \
        if ((TT).gk) { const float* g_ = (TT).gk + kk0; r0 *= g_[0]; r1 *= g_[8]; r2 *= g_[16]; r3 *= g_[24]; r4 *= g_[32]; r5 *= g_[40]; r6 *= g_[48]; r7 *= g_[56]; } } while (0)
    if (id < NT) { T = wt_decode(p, id); WT_LOAD(T); }
#pragma unroll 1
    for (; id < NT; id += gridDim.x) {
        { float* tp = t + kk0 * 65 + nn; tp[0] = r0; tp[8 * 65] = r1; tp[16 * 65] = r2; tp[24 * 65] = r3; tp[32 * 65] = r4; tp[40 * 65] = r5; tp[48 * 65] = r6; tp[56 * 65] = r7; }
        WtTile Tn = T; const bool more = id + (int)gridDim.x < NT;
        if (more) { Tn = wt_decode(p, id + (int)gridDim.x); WT_LOAD(Tn); }
        __syncthreads();
        { const int kk = (tid & 31) * 2, nn0 = tid >> 5;
#pragma unroll
          for (int i = 0; i < 4; ++i) { const int n2 = nn0 + 16 * i; *(unsigned*)(T.dst + (size_t)n2 * T.ldd + kk) = cvt_pk_bf16(t[kk * 65 + n2], t[(kk + 1) * 65 + n2]); } }
        __syncthreads();
        T = Tn;
    }
#undef WT_LOAD
    float* cosT = (float*)(p.ws + OFF_ROPE); float* sinT = cosT + 8192 * 32;
    for (int e = blockIdx.x * 512 + threadIdx.x; e < 8192 * 32; e += gridDim.x * 512) {
        const int pos = e >> 5, i = e & 31;
        const float inv = (float)exp(-(double)i * (9.210340371976184 / 32.0));
        const float ang = (float)pos * inv;
        const double rev = (double)ang * 0.15915494309189535; const float fr = (float)(rev - rint(rev));
        cosT[e] = __builtin_amdgcn_cosf(fr); sinT[e] = __builtin_amdgcn_sinf(fr);
    }
}

template <bool WITH_DT, bool XF32>
__device__ __forceinline__ void phase_resid(const float* __restrict__ xf, bf16_t* xb, const bf16_t* delta, bf16_t* hn, const float* __restrict__ g, const float* w_in_l, const float* dt_bias, float* dtbuf, unsigned char* shm) {
    int tid0_ = threadIdx.x; asm volatile("" : "+v"(tid0_)); const int tid = tid0_, lane = tid & 63, wid = tid >> 6;
    bf16_t* wlb = (bf16_t*)shm;
    constexpr int RG = WITH_DT ? 16 : 1;
    if (WITH_DT) {
        for (int k = tid; k < 2048; k += 512) {
            const float4* s = (const float4*)(w_in_l + (size_t)k * INW + 2560); const float gk = g[k];
#pragma unroll
            for (int q = 0; q < 4; ++q) { const float4 v = s[q]; wlb[(4 * q + 0) * 2056 + k] = f2bf(v.x * gk); wlb[(4 * q + 1) * 2056 + k] = f2bf(v.y * gk); wlb[(4 * q + 2) * 2056 + k] = f2bf(v.z * gk); wlb[(4 * q + 3) * 2056 + k] = f2bf(v.w * gk); } }
        __syncthreads();
    }
#pragma unroll 1
    for (int rowg = (blockIdx.x * 8 + wid) * RG; rowg < NTOK; rowg += gridDim.x * 8 * RG) {
#pragma unroll 1
        for (int row = rowg; row < rowg + RG; ++row) {
            float4 v[8];
            if (XF32) {
#pragma unroll
                for (int i = 0; i < 8; ++i) v[i] = *(const float4*)(xf + (size_t)row * DM + i * 256 + lane * 4);
            } else {
                uint2 xr[8];
#pragma unroll
                for (int i = 0; i < 8; ++i) xr[i] = *(const uint2*)(xb + (size_t)row * DM + i * 256 + lane * 4);
#pragma unroll
                for (int i = 0; i < 8; ++i) { float x4[4]; unpack4(xr[i], x4); v[i].x = x4[0]; v[i].y = x4[1]; v[i].z = x4[2]; v[i].w = x4[3]; }
            }
            if (delta) {
                uint2 dl[8];
#pragma unroll
                for (int i = 0; i < 8; ++i) dl[i] = *(const uint2*)(delta + (size_t)row * DM + i * 256 + lane * 4);
#pragma unroll
                for (int i = 0; i < 8; ++i) { float d4[4]; unpack4(dl[i], d4); v[i].x += d4[0]; v[i].y += d4[1]; v[i].z += d4[2]; v[i].w += d4[3]; }
            }
            float ss = 0.f;
#pragma unroll
            for (int i = 0; i < 8; ++i) ss += v[i].x * v[i].x + v[i].y * v[i].y + v[i].z * v[i].z + v[i].w * v[i].w;
#pragma unroll
            for (int o = 32; o >= 1; o >>= 1) ss += __shfl_xor(ss, o);
            const float rstd = rsqrtf(ss * (1.0f / DM) + 1e-6f);
#pragma unroll
            for (int i = 0; i < 8; ++i) {
                if (XF32 || delta) *(uint2*)(xb + (size_t)row * DM + i * 256 + lane * 4) = pack4u(v[i].x, v[i].y, v[i].z, v[i].w);
                *(uint2*)(hn + (size_t)row * DM + i * 256 + lane * 4) = pack4u(v[i].x * rstd, v[i].y * rstd, v[i].z * rstd, v[i].w * rstd); }
        }
        if (WITH_DT) {
            const int lr = lane & 15, g4 = lane >> 4;
            __builtin_amdgcn_fence(__ATOMIC_RELEASE, "workgroup"); asm volatile("s_waitcnt vmcnt(0)" ::: "memory"); __builtin_amdgcn_fence(__ATOMIC_ACQUIRE, "workgroup");
            f32x4 acc = F4ZERO;
            const bf16_t* ap = hn + (size_t)(rowg + lr) * DM + g4 * 8; const bf16_t* bp = wlb + lr * 2056 + g4 * 8;
#pragma unroll 8
            for (int ks = 0; ks < 64; ++ks) acc = mfma16(*(const bf16x8*)(ap + ks * 32), *(const bf16x8*)(bp + ks * 32), acc);
            const float bias = dt_bias[lr];
#pragma unroll
            for (int q = 0; q < 4; ++q) { const float xv = acc[q] + bias; dtbuf[(size_t)(rowg + 4 * g4 + q) * 16 + lr] = fmaxf(xv, 0.f) + log1pf(__expf(-fabsf(xv))); }
        }
    }
    __syncthreads();
}

#ifndef GEMM_SP2
#define GEMM_SP2 true
#endif
#ifndef GEMM_ALIGN
#define GEMM_ALIGN true
#endif
template <class Epi>
__device__ __forceinline__ void run_gemm(unsigned char* shm, const bf16_t* A, const bf16_t* Bt, int M, int N, int K, const Epi& E, int vb, unsigned long long* pst = nullptr) {
    pg8::Gemm g; g.A = A; g.Bt = Bt; g.M = M; g.N = N; g.K = K;
    pg8::StaticOrder S; S.init(M, N, (int)gridDim.x, vb);
    (void)pst; pg8::gemm_phase<Epi, pg8::StaticOrder, GEMM_ALIGN, GEMM_SP2>((PG8_LAS unsigned char*)shm, g, S, E);
    __syncthreads();
}

__device__ __forceinline__ void rope8(float* v, const float* cosT, const float* sinT, int t, int sub, float sc) {
    const float* cp = cosT + t * 32 + (sub & 3) * 8; const float* sp = sinT + t * 32 + (sub & 3) * 8;
    const float4 c0 = *(const float4*)cp, c1 = *(const float4*)(cp + 4), s0 = *(const float4*)sp, s1 = *(const float4*)(sp + 4);
    const float cc[8] = {c0.x, c0.y, c0.z, c0.w, c1.x, c1.y, c1.z, c1.w}; const float sn[8] = {s0.x, s0.y, s0.z, s0.w, s1.x, s1.y, s1.z, s1.w};
#pragma unroll
    for (int i = 0; i < 8; ++i) { const float pv = __shfl_xor(v[i], 4); v[i] = ((sub < 4) ? (v[i] * cc[i] - pv * sn[i]) : (pv * sn[i] + v[i] * cc[i])) * sc; }
}
__device__ __forceinline__ void phase_pre(const Params& p, int layer) {
    int tid0_ = threadIdx.x; asm volatile("" : "+v"(tid0_)); const int tid = tid0_;
    bf16_t* proj = (bf16_t*)(p.ws + OFF_PROJ); bf16_t* xc = (bf16_t*)(p.ws + OFF_XC);
    const float* cosT = (const float*)(p.ws + OFF_ROPE); const float* sinT = cosT + 8192 * 32;
    const float* cw = p.conv_w + layer * 4 * 1536; const float* cb = p.conv_b + layer * 1536;
    for (int it = blockIdx.x; it < 256; it += gridDim.x) {
        if (tid < 384) {
            const int cg = tid % 192, half = tid / 192, ch = cg * 8, c = it & 63, l0 = half * 64;
            const size_t tokbase = (size_t)it * 128;
            float wk[4][8], bias[8];
            { const float4 b0 = *(const float4*)(cb + ch), b1 = *(const float4*)(cb + ch + 4); bias[0] = b0.x; bias[1] = b0.y; bias[2] = b0.z; bias[3] = b0.w; bias[4] = b1.x; bias[5] = b1.y; bias[6] = b1.z; bias[7] = b1.w; }
#pragma unroll
            for (int k = 0; k < 4; ++k) { const float4 w0 = *(const float4*)(cw + k * 1536 + ch), w1 = *(const float4*)(cw + k * 1536 + ch + 4);
                wk[k][0] = w0.x; wk[k][1] = w0.y; wk[k][2] = w0.z; wk[k][3] = w0.w; wk[k][4] = w1.x; wk[k][5] = w1.y; wk[k][6] = w1.z; wk[k][7] = w1.w; }
            float h0[8], h1[8], h2[8];
            { uint4 r0 = make_uint4(0u, 0u, 0u, 0u), r1 = r0, r2 = r0;
              if (c * 128 + l0 - 3 >= 0) { r0 = *(const uint4*)(proj + (tokbase + l0 - 3) * LDP + PXBC + ch); r1 = *(const uint4*)(proj + (tokbase + l0 - 2) * LDP + PXBC + ch); r2 = *(const uint4*)(proj + (tokbase + l0 - 1) * LDP + PXBC + ch); }
              unpack8(r0, h0); unpack8(r1, h1); unpack8(r2, h2); }
#pragma unroll 1
            for (int lb = 0; lb < 64; lb += 8) {
                uint4 raw[8];
#pragma unroll
                for (int i = 0; i < 8; ++i) raw[i] = *(const uint4*)(proj + (tokbase + l0 + lb + i) * LDP + PXBC + ch);
#pragma unroll
                for (int i = 0; i < 8; ++i) { float xv[8], o[8]; unpack8(raw[i], xv);
#pragma unroll
                    for (int e = 0; e < 8; ++e) { o[e] = silu_f(bias[e] + wk[0][e] * h0[e] + wk[1][e] * h1[e] + wk[2][e] * h2[e] + wk[3][e] * xv[e]); h0[e] = h1[e]; h1[e] = h2[e]; h2[e] = xv[e]; }
                    *(uint4*)(xc + (tokbase + l0 + lb + i) * 1536 + ch) = pack8u(o); }
            }
        }
    }
    const int sub = tid & 7, grp = (blockIdx.x * 512 + tid) >> 3, ngrp = gridDim.x * 64;
    const float* qg = p.q_norm + layer * 64; const float* kg = p.k_norm + layer * 64;
#pragma unroll 4
    for (int rt = grp; rt < NTOK * 16; rt += ngrp) {
        const int tok = rt >> 4, hk = rt & 15; bf16_t* ptr = proj + (size_t)tok * LDP + PAQ + hk * 64 + sub * 8;
        float v[8]; unpack8(*(const uint4*)ptr, v);
        float ss = 0.f;
#pragma unroll
        for (int i = 0; i < 8; ++i) ss += v[i] * v[i];
        ss += __shfl_xor(ss, 1); ss += __shfl_xor(ss, 2); ss += __shfl_xor(ss, 4);
        const float rstd = rsqrtf(ss * (1.0f / 64.0f) + 1e-6f);
        const float* gp = (hk < 8 ? qg : kg) + sub * 8; const float4 g0 = *(const float4*)gp, g1 = *(const float4*)(gp + 4);
        v[0] *= rstd * g0.x; v[1] *= rstd * g0.y; v[2] *= rstd * g0.z; v[3] *= rstd * g0.w; v[4] *= rstd * g1.x; v[5] *= rstd * g1.y; v[6] *= rstd * g1.z; v[7] *= rstd * g1.w;
        rope8(v, cosT, sinT, tok & (SEQ - 1), sub, hk < 8 ? 0.125f : 1.0f);
        *(uint4*)ptr = pack8u(v);
    }
}

template <int W>
__device__ __forceinline__ void stage_tr(const bf16_t* __restrict__ src, int ld, size_t tokbase, bf16_t* dst, int stride, const float* rs, int tid) {
    const int l = tid & 127, cgi = tid >> 7;
    uint4 raw[W / 32];
#pragma unroll
    for (int it = 0; it < W / 32; ++it) raw[it] = *(const uint4*)(src + (tokbase + l) * ld + cgi * 8 + 32 * it);
    if (rs) { const float sc = rs[l];
#pragma unroll
        for (int it = 0; it < W / 32; ++it) { float v[8]; unpack8(raw[it], v);
#pragma unroll
            for (int i = 0; i < 8; ++i) v[i] *= sc;
            raw[it] = pack8u(v); } }
#pragma unroll
    for (int it = 0; it < W / 32; ++it) { bf16_t* vp = dst + (cgi * 8 + 32 * it) * stride + l; const uint4 r = raw[it];
        vp[0] = (bf16_t)(r.x & 0xffffu); vp[stride] = (bf16_t)(r.x >> 16); vp[2 * stride] = (bf16_t)(r.y & 0xffffu); vp[3 * stride] = (bf16_t)(r.y >> 16);
        vp[4 * stride] = (bf16_t)(r.z & 0xffffu); vp[5 * stride] = (bf16_t)(r.z >> 16); vp[6 * stride] = (bf16_t)(r.w & 0xffffu); vp[7 * stride] = (bf16_t)(r.w >> 16); }
}
template <int W>
__device__ __forceinline__ void stage_nat(const bf16_t* __restrict__ src, int ld, size_t tokbase, bf16_t* dst, int stride, int tid) {
    constexpr int CG = W / 8, RP = 512 / CG, NP = 128 / RP;
    const int cg = tid % CG, r0 = tid / CG;
    uint4 raw[NP];
#pragma unroll
    for (int it = 0; it < NP; ++it) raw[it] = *(const uint4*)(src + (tokbase + r0 + it * RP) * ld + cg * 8);
#pragma unroll
    for (int it = 0; it < NP; ++it) *(uint4*)(dst + (r0 + it * RP) * stride + cg * 8) = raw[it];
}

__device__ __forceinline__ float head_acum(const float* __restrict__ dtbuf, size_t tokbase, int hh, float a_neg, int lane, float& d0, float& d1, float& ac0, float& ac1) {
    const int l0 = 2 * lane;
    d0 = dtbuf[(tokbase + l0) * 16 + hh]; d1 = dtbuf[(tokbase + l0 + 1) * 16 + hh];
    const float v0 = d0 * a_neg, v1 = d1 * a_neg; float s = v0 + v1;
#pragma unroll
    for (int o = 1; o < 64; o <<= 1) { const float t = __shfl_up(s, o); if (lane >= o) s += t; }
    ac0 = s - v1; ac1 = s;
    return __shfl(s, 63);
}

struct AttId { int b, h, br, d, r, n; };
__device__ __forceinline__ AttId att_decode(int idx) {
    AttId a; a.br = idx >> 11; const int rem = idx & 2047, bh = rem >> 6, jj = rem & 63, dsh = 2 * a.br;
    a.d = 1 << dsh; a.r = jj >> (6 - dsh); a.n = jj & ((64 >> dsh) - 1); a.b = bh >> 3; a.h = bh & 7; return a;
}
__device__ __forceinline__ void att_run(const Params& p, int u0, int cnt, unsigned char* shm) {
    int tid0_ = threadIdx.x; asm volatile("" : "+v"(tid0_)); const int tid = tid0_, lane = tid & 63, w = __builtin_amdgcn_readfirstlane(tid >> 6), lr = lane & 15, g4 = lane >> 4;
    if (cnt <= 0) return;
    bf16_t* Qs = (bf16_t*)shm; bf16_t* Ks = Qs + 128 * 72; bf16_t* Vt = Ks + 256 * 72;
    const bf16_t* proj = (const bf16_t*)(p.ws + OFF_PROJ);
    const int sub = tid & 7, rloc = tid >> 3;
    AttId a = att_decode(u0);
    uint4 rq0, rq1, rk0, rk1, rv0, rv1;
    { const bf16_t* base = proj + ((size_t)a.b * SEQ + a.r) * LDP + a.h * 64 + sub * 8; const size_t rs = (size_t)a.d * LDP;
      { const bf16_t* rp = base + (size_t)(a.n * 128 + rloc) * rs; rq0 = *(const uint4*)(rp + PAQ); rk0 = *(const uint4*)(rp + PAK); rv0 = *(const uint4*)(rp + PAV); }
      { const bf16_t* rp = base + (size_t)(a.n * 128 + 64 + rloc) * rs; rq1 = *(const uint4*)(rp + PAQ); rk1 = *(const uint4*)(rp + PAK); rv1 = *(const uint4*)(rp + PAV); }
      if (a.n > 0) {
          const int ps_slot = (a.n - 1) & 1;
#pragma unroll
          for (int ps = 0; ps < 2; ++ps) { const int li = ps * 64 + rloc; const bf16_t* rp = base + (size_t)((a.n - 1) * 128 + li) * rs;
              const uint4 k = *(const uint4*)(rp + PAK), v = *(const uint4*)(rp + PAV);
              *(uint4*)(Ks + (ps_slot * 128 + li) * 72 + sub * 8) = k;
              bf16_t* vp = Vt + (sub * 8) * 264 + ps_slot * 128 + li;
              vp[0] = (bf16_t)(v.x & 0xffffu); vp[264] = (bf16_t)(v.x >> 16); vp[528] = (bf16_t)(v.y & 0xffffu); vp[792] = (bf16_t)(v.y >> 16);
              vp[1056] = (bf16_t)(v.z & 0xffffu); vp[1320] = (bf16_t)(v.z >> 16); vp[1584] = (bf16_t)(v.w & 0xffffu); vp[1848] = (bf16_t)(v.w >> 16); } } }
#pragma unroll 1
    for (int k = 0; k < cnt; ++k) {
        const int slot = a.n & 1;
        if (a.n == 0) { const uint4 z = make_uint4(0u, 0u, 0u, 0u); bf16_t* zp = Vt + (tid >> 3) * 264 + 128 + (tid & 7) * 16; *(uint4*)zp = z; *(uint4*)(zp + 8) = z; }
#pragma unroll
        for (int ps = 0; ps < 2; ++ps) { const int li = ps * 64 + rloc;
            *(uint4*)(Qs + li * 72 + sub * 8) = ps ? rq1 : rq0; *(uint4*)(Ks + (slot * 128 + li) * 72 + sub * 8) = ps ? rk1 : rk0;
            bf16_t* vp = Vt + (sub * 8) * 264 + slot * 128 + li; const uint4 v = ps ? rv1 : rv0;
            vp[0] = (bf16_t)(v.x & 0xffffu); vp[264] = (bf16_t)(v.x >> 16); vp[528] = (bf16_t)(v.y & 0xffffu); vp[792] = (bf16_t)(v.y >> 16);
            vp[1056] = (bf16_t)(v.z & 0xffffu); vp[1320] = (bf16_t)(v.z >> 16); vp[1584] = (bf16_t)(v.w & 0xffffu); vp[1848] = (bf16_t)(v.w >> 16); }
        const bool has_next = (k + 1 < cnt);
        AttId nx = a;
        if (has_next) { nx = att_decode(u0 + k + 1);
            const bf16_t* base = proj + ((size_t)nx.b * SEQ + nx.r) * LDP + nx.h * 64 + sub * 8; const size_t rs = (size_t)nx.d * LDP;
            { const bf16_t* rp = base + (size_t)(nx.n * 128 + rloc) * rs; rq0 = *(const uint4*)(rp + PAQ); rk0 = *(const uint4*)(rp + PAK); rv0 = *(const uint4*)(rp + PAV); }
            { const bf16_t* rp = base + (size_t)(nx.n * 128 + 64 + rloc) * rs; rq1 = *(const uint4*)(rp + PAQ); rk1 = *(const uint4*)(rp + PAK); rv1 = *(const uint4*)(rp + PAV); } }
        __syncthreads();
        const int iq = 16 * w + lr, n = a.n;
        bf16x8 qf[2];
#pragma unroll
        for (int ks = 0; ks < 2; ++ks) qf[ks] = *(const bf16x8*)(Qs + iq * 72 + ks * 32 + g4 * 8);
        f32x4 s[9]; float mx = -INFINITY;
#pragma unroll
        for (int i = 0; i < 9; ++i) { f32x4 acc = F4ZERO; const int T = w + i; const int krow = (((T < 8) ? (slot ^ 1) : slot) * 128) + (T & 7) * 16 + lr;
#pragma unroll
            for (int ks = 0; ks < 2; ++ks) acc = mfma16(*(const bf16x8*)(Ks + krow * 72 + ks * 32 + g4 * 8), qf[ks], acc);
#pragma unroll
            for (int q = 0; q < 4; ++q) {
                const int dq = 4 * g4 + q - lr; bool ok = (i == 0) ? (dq >= 0) : ((i == 8) ? (dq <= 0) : true);
                if (n == 0) ok = ok && (T >= 8);
                acc[q] = ok ? acc[q] : -INFINITY; mx = fmaxf(mx, acc[q]); }
            s[i] = acc; }
        mx = fmaxf(mx, __shfl_xor(mx, 16)); mx = fmaxf(mx, __shfl_xor(mx, 32));
        float den = 0.f; const float mx2 = mx * 1.4426950408889634f;
#pragma unroll
        for (int i = 0; i < 9; ++i)
#pragma unroll
            for (int q = 0; q < 4; ++q) { const float e = __builtin_amdgcn_exp2f(__builtin_fmaf(s[i][q], 1.4426950408889634f, -mx2)); s[i][q] = e; den += e; }
        den += __shfl_xor(den, 16); den += __shfl_xor(den, 32);
        f32x4 o[4] = {F4ZERO, F4ZERO, F4ZERO, F4ZERO};
#pragma unroll
        for (int pi = 0; pi < 5; ++pi) {
            const f32x4 p0 = s[2 * pi], p1 = (2 * pi + 1 < 9) ? s[(2 * pi + 1 < 9) ? 2 * pi + 1 : 0] : F4ZERO;
            uint4 pw; pw.x = cvt_pk_bf16(p0[0], p0[1]); pw.y = cvt_pk_bf16(p0[2], p0[3]); pw.z = cvt_pk_bf16(p1[0], p1[1]); pw.w = cvt_pk_bf16(p1[2], p1[3]);
            const bf16x8 pf = as_bf8(pw);
            const int T0 = w + 2 * pi, T1 = (T0 + 1 < 16) ? T0 + 1 : 15;
            const int c0 = (((T0 < 8) ? (slot ^ 1) : slot) * 128) + (T0 & 7) * 16 + 4 * g4, c1 = (((T1 < 8) ? (slot ^ 1) : slot) * 128) + (T1 & 7) * 16 + 4 * g4;
#pragma unroll
            for (int dt = 0; dt < 4; ++dt) { const bf16_t* vr = Vt + (dt * 16 + lr) * 264;
                o[dt] = mfma16(cat4(*(const bf16x4*)(vr + c0), *(const bf16x4*)(vr + c1)), pf, o[dt]); }
        }
        const float inv = 1.0f / den;
        const size_t tok = (size_t)a.b * SEQ + (size_t)(n * 128 + iq) * a.d + a.r;
        bf16_t* op = (bf16_t*)p.out + ((size_t)a.br * NTOK + tok) * 512 + a.h * 64;
#pragma unroll
        for (int dt = 0; dt < 4; ++dt) *(uint2*)(op + dt * 16 + 4 * g4) = pack4u(o[dt][0] * inv, o[dt][1] * inv, o[dt][2] * inv, o[dt][3] * inv);
        if (g4 == 0) ((float*)(p.ws + OFF_LSE))[((size_t)a.br * NTOK + tok) * 8 + a.h] = mx + __logf(den);
        __syncthreads();
        a = nx;
    }
}

__device__ __forceinline__ void ssd_state_item(const Params& p, int layer, int idx, unsigned char* shm) {
    int tid0_ = threadIdx.x; asm volatile("" : "+v"(tid0_)); const int tid = tid0_, lane = tid & 63, w = __builtin_amdgcn_readfirstlane(tid >> 6), lr = lane & 15, g4 = lane >> 4;
    const int g = idx & 1, bc = idx >> 1;
    const size_t tokbase = (size_t)bc * 128;
    bf16_t* Bt = (bf16_t*)shm; bf16_t* Xt = Bt + 128 * 136; float* wsc = (float*)(shm + 52224);
    const bf16_t* xc = (const bf16_t*)(p.ws + OFF_XC);
    const float* dtbuf = (const float*)(p.ws + OFF_DT);
    { const int hh = 8 * g + w; float d0, d1, a0, a1;
      const float tot = head_acum(dtbuf, tokbase, hh, -__expf(p.a_log[layer * 16 + hh]), lane, d0, d1, a0, a1);
      wsc[w * 128 + 2 * lane] = __expf(tot - a0) * d0; wsc[w * 128 + 2 * lane + 1] = __expf(tot - a1) * d1;
      if (lane == 0) ((float*)(p.ws + OFF_CDEC))[bc * 16 + hh] = __expf(tot); }
    const int sl = tid & 127, scg = tid >> 7;
    uint4 xa, xb2;
    { const bf16_t* xs = xc + (tokbase + sl) * 1536 + (8 * g) * 64 + scg * 8; xa = *(const uint4*)xs; xb2 = *(const uint4*)(xs + 32); }
    stage_tr<128>(xc + 1024 + g * 128, 1536, tokbase, Bt, 136, nullptr, tid);
#pragma unroll 1
    for (int j = 0; j < 8; ++j) {
        const int hh = 8 * g + j;
        __syncthreads();
        { const float sc = wsc[j * 128 + sl];
#pragma unroll
          for (int it = 0; it < 2; ++it) { float v[8]; unpack8(it ? xb2 : xa, v);
#pragma unroll
              for (int i = 0; i < 8; ++i) Xt[(scg * 8 + 32 * it + i) * 136 + sl] = f2bf(v[i] * sc); } }
        if (j < 7) { const bf16_t* xs = xc + (tokbase + sl) * 1536 + (hh + 1) * 64 + scg * 8; xa = *(const uint4*)xs; xb2 = *(const uint4*)(xs + 32); }
        __syncthreads();
        f32x4 acc[4] = {F4ZERO, F4ZERO, F4ZERO, F4ZERO};
#pragma unroll
        for (int ks = 0; ks < 4; ++ks) { const bf16x8 af = *(const bf16x8*)(Bt + (w * 16 + lr) * 136 + ks * 32 + g4 * 8);
#pragma unroll
            for (int pt = 0; pt < 4; ++pt) acc[pt] = mfma16(af, *(const bf16x8*)(Xt + (pt * 16 + lr) * 136 + ks * 32 + g4 * 8), acc[pt]); }
        bf16_t* sp = (bf16_t*)(p.ws + OFF_SST) + ((size_t)bc * 16 + hh) * 8192;
#pragma unroll
        for (int pt = 0; pt < 4; ++pt) *(uint2*)(sp + (pt * 16 + lr) * 128 + w * 16 + 4 * g4) = pack4u(acc[pt][0], acc[pt][1], acc[pt][2], acc[pt][3]);
    }
    __syncthreads();
}

__device__ __forceinline__ void ret_state_item(const Params& p, int idx, unsigned char* shm) {
    int tid0_ = threadIdx.x; asm volatile("" : "+v"(tid0_)); const int tid = tid0_, lane = tid & 63, w = __builtin_amdgcn_readfirstlane(tid >> 6), lr = lane & 15, g4 = lane >> 4;
    const int h = idx & 3, bc = idx >> 2;
    const size_t tokbase = (size_t)bc * 128;
    bf16_t* Kt = (bf16_t*)shm; bf16_t* Vt = Kt + 64 * 136; float* wsc = (float*)(shm + 52224);
    const bf16_t* proj = (const bf16_t*)(p.ws + OFF_PROJ);
    const float lg = log1pf(-exp2f(-5.0f - (float)h));
    if (tid < 128) wsc[tid] = __expf((float)(127 - tid) * lg);
    stage_tr<128>(proj + PRV + h * 128, LDP, tokbase, Vt, 136, nullptr, tid);
    __syncthreads();
    { const int l = tid & 127, cgi = tid >> 7, t = (bc & 63) * 128 + l;
      const float* cosT = (const float*)(p.ws + OFF_ROPE); const float* sinT = cosT + 8192 * 32;
      const bf16_t* src = proj + (tokbase + l) * LDP + PRK + h * 64 + cgi * 8;
      float v1[8], v2[8]; unpack8(*(const uint4*)src, v1); unpack8(*(const uint4*)(src + 32), v2);
      const float* cp = cosT + t * 32 + cgi * 8; const float* sp = sinT + t * 32 + cgi * 8;
      const float4 c0 = *(const float4*)cp, c1 = *(const float4*)(cp + 4), s0 = *(const float4*)sp, s1 = *(const float4*)(sp + 4);
      const float cc[8] = {c0.x, c0.y, c0.z, c0.w, c1.x, c1.y, c1.z, c1.w}; const float sn[8] = {s0.x, s0.y, s0.z, s0.w, s1.x, s1.y, s1.z, s1.w};
      const float sc = 0.125f * wsc[l];
#pragma unroll
      for (int i = 0; i < 8; ++i) { Kt[(cgi * 8 + i) * 136 + l] = f2bf((v1[i] * cc[i] - v2[i] * sn[i]) * sc); Kt[(32 + cgi * 8 + i) * 136 + l] = f2bf((v1[i] * sn[i] + v2[i] * cc[i]) * sc); } }
    __syncthreads();
    f32x4 acc[4] = {F4ZERO, F4ZERO, F4ZERO, F4ZERO};
#pragma unroll
    for (int ks = 0; ks < 4; ++ks) { const bf16x8 bfr = *(const bf16x8*)(Vt + (w * 16 + lr) * 136 + ks * 32 + g4 * 8);
#pragma unroll
        for (int dt = 0; dt < 4; ++dt) acc[dt] = mfma16(*(const bf16x8*)(Kt + (dt * 16 + lr) * 136 + ks * 32 + g4 * 8), bfr, acc[dt]); }
    float* rp = (float*)(p.ws + OFF_RST) + ((size_t)bc * 4 + h) * 8192 + (w * 16 + lr) * 64;
#pragma unroll
    for (int dt = 0; dt < 4; ++dt) *(f32x4*)(rp + dt * 16 + 4 * g4) = acc[dt];
    __syncthreads();
}
__device__ __forceinline__ void phase_scan(const Params& p) {
    int tid0_ = threadIdx.x; asm volatile("" : "+v"(tid0_)); const int nth = gridDim.x * 512, gid = blockIdx.x * 512 + tid0_;
    const float* cdec = (const float*)(p.ws + OFF_CDEC);
    for (int it = gid; it < 131072; it += nth) {
        const int n4 = it & 31, pp = (it >> 5) & 63, hh = (it >> 11) & 15, b = it >> 15;
        const int rd = it & 63, re = (it >> 6) & 127, rh = (it >> 13) & 3;
        float st[4] = {0.f, 0.f, 0.f, 0.f}; float rs = 0.f;
        const float rdec = __expf(128.0f * log1pf(-exp2f(-5.0f - (float)rh)));
        bf16_t* base = (bf16_t*)(p.ws + OFF_SST) + ((size_t)(b * 64) * 16 + hh) * 8192 + pp * 128 + n4 * 4;
        float* rbase = (float*)(p.ws + OFF_RST) + ((size_t)(b * 64) * 4 + rh) * 8192 + re * 64 + rd;
#pragma unroll 8
        for (int c = 0; c < 64; ++c) {
            uint2* a = (uint2*)(base + (size_t)c * 16 * 8192); const uint2 raw = *a; const float dec = cdec[(b * 64 + c) * 16 + hh];
            float* ra = rbase + (size_t)c * 4 * 8192; const float rv = *ra;
            float v[4]; unpack4(raw, v);
            *a = pack4u(st[0], st[1], st[2], st[3]); *ra = rs;
            st[0] = st[0] * dec + v[0]; st[1] = st[1] * dec + v[1]; st[2] = st[2] * dec + v[2]; st[3] = st[3] * dec + v[3];
            rs = rs * rdec + rv;
        }
    }
    const bf16_t* ao = (const bf16_t*)p.out; const float* lse = (const float*)(p.ws + OFF_LSE); bf16_t* y = (bf16_t*)(p.ws + OFF_Y);
    for (int it = gid; it < NTOK * 64; it += nth) {
        const int sub = it & 7, h = (it >> 3) & 7, tok = it >> 6;
        const float l0 = lse[(size_t)tok * 8 + h], l1 = lse[((size_t)NTOK + tok) * 8 + h], l2 = lse[((size_t)2 * NTOK + tok) * 8 + h];
        const float m = fmaxf(l0, fmaxf(l1, l2)); float w0 = __expf(l0 - m), w1 = __expf(l1 - m), w2 = __expf(l2 - m); const float inv = 1.0f / (w0 + w1 + w2); w0 *= inv; w1 *= inv; w2 *= inv;
        float a0[8], a1[8], a2[8], o[8];
        unpack8(*(const uint4*)(ao + (size_t)tok * 512 + h * 64 + sub * 8), a0);
        unpack8(*(const uint4*)(ao + ((size_t)NTOK + tok) * 512 + h * 64 + sub * 8), a1);
        unpack8(*(const uint4*)(ao + ((size_t)2 * NTOK + tok) * 512 + h * 64 + sub * 8), a2);
#pragma unroll
        for (int i = 0; i < 8; ++i) o[i] = w0 * a0[i] + w1 * a1[i] + w2 * a2[i];
        *(uint4*)(y + (size_t)tok * DM + 1024 + h * 64 + sub * 8) = pack8u(o);
    }
}

__device__ __forceinline__ void ssd_out_item(const Params& p, int layer, int idx, unsigned char* shm) {
    int tid0_ = threadIdx.x; asm volatile("" : "+v"(tid0_)); const int tid = tid0_, lane = tid & 63, w = __builtin_amdgcn_readfirstlane(tid >> 6), lr = lane & 15, g4 = lane >> 4;
    const int g = idx & 1, bc = idx >> 1;
    const size_t tokbase = (size_t)bc * 128;
    bf16_t* Cs = (bf16_t*)shm; bf16_t* Bs = Cs + 128 * 136; bf16_t* Xt = Bs + 128 * 136; bf16_t* Pv = Xt + 64 * 136;
    float* dts = (float*)(shm + 104448); float* acs = dts + 8 * 128;
    const bf16_t* proj = (const bf16_t*)(p.ws + OFF_PROJ); const bf16_t* xc = (const bf16_t*)(p.ws + OFF_XC);
    const float* dtbuf = (const float*)(p.ws + OFF_DT);
    bf16_t* y = (bf16_t*)(p.ws + OFF_Y);
    const int sl = tid & 127, scg = tid >> 7;
    uint4 xr0, xr1, pr0, pr1;
    { const bf16_t* xs = xc + (tokbase + sl) * 1536 + (8 * g) * 64 + scg * 8; xr0 = *(const uint4*)xs; xr1 = *(const uint4*)(xs + 32);
      const bf16_t* ps = (const bf16_t*)(p.ws + OFF_SST) + ((size_t)bc * 16 + 8 * g) * 8192 + tid * 8; pr0 = *(const uint4*)ps; pr1 = *(const uint4*)(ps + 4096); }
    { const int hh = 8 * g + w; float d0, d1, a0, a1;
      (void)head_acum(dtbuf, tokbase, hh, -__expf(p.a_log[layer * 16 + hh]), lane, d0, d1, a0, a1);
      dts[w * 128 + 2 * lane] = d0; dts[w * 128 + 2 * lane + 1] = d1; acs[w * 128 + 2 * lane] = a0; acs[w * 128 + 2 * lane + 1] = a1; }
    stage_nat<128>(xc + 1280 + g * 128, 1536, tokbase, Cs, 136, tid);
    stage_nat<128>(xc + 1024 + g * 128, 1536, tokbase, Bs, 136, tid);
    __syncthreads();
    const int l = w * 16 + lr;
    bf16x8 cf[4];
#pragma unroll
    for (int ks = 0; ks < 4; ++ks) cf[ks] = *(const bf16x8*)(Cs + l * 136 + ks * 32 + g4 * 8);
    f32x4 cbt[8];
#pragma unroll
    for (int st = 0; st < 8; ++st) { cbt[st] = F4ZERO;
        if (st <= w) {
#pragma unroll
            for (int ks = 0; ks < 4; ++ks) cbt[st] = mfma16(*(const bf16x8*)(Bs + (st * 16 + lr) * 136 + ks * 32 + g4 * 8), cf[ks], cbt[st]); } }
    float ssq = 0.f;
    const size_t tok = tokbase + l;
#pragma unroll 1
    for (int j = 0; j < 8; ++j) {
        const int hh = 8 * g + j;
        __syncthreads();
#pragma unroll
        for (int it = 0; it < 2; ++it) { bf16_t* vp = Xt + (scg * 8 + 32 * it) * 136 + sl; const uint4 r = it ? xr1 : xr0;
            vp[0] = (bf16_t)(r.x & 0xffffu); vp[136] = (bf16_t)(r.x >> 16); vp[272] = (bf16_t)(r.y & 0xffffu); vp[408] = (bf16_t)(r.y >> 16);
            vp[544] = (bf16_t)(r.z & 0xffffu); vp[680] = (bf16_t)(r.z >> 16); vp[816] = (bf16_t)(r.w & 0xffffu); vp[952] = (bf16_t)(r.w >> 16);
            const int e = tid * 8 + it * 4096; *(uint4*)(Pv + (e >> 7) * 136 + (e & 127)) = it ? pr1 : pr0; }
        if (j < 7) { const bf16_t* xs = xc + (tokbase + sl) * 1536 + (hh + 1) * 64 + scg * 8; xr0 = *(const uint4*)xs; xr1 = *(const uint4*)(xs + 32);
            const bf16_t* ps = (const bf16_t*)(p.ws + OFF_SST) + ((size_t)bc * 16 + hh + 1) * 8192 + tid * 8; pr0 = *(const uint4*)ps; pr1 = *(const uint4*)(ps + 4096); }
        __syncthreads();
        const float* dth = dts + j * 128; const float* ach = acs + j * 128;
        const float al = ach[l], dsk = p.d_skip[layer * 16 + hh];
        uint2 zr[4];
#pragma unroll
        for (int pt = 0; pt < 4; ++pt) zr[pt] = *(const uint2*)(proj + tok * LDP + hh * 64 + pt * 16 + 4 * g4);
        f32x4 acc[4] = {F4ZERO, F4ZERO, F4ZERO, F4ZERO};
#pragma unroll
        for (int sp = 0; sp < 4; ++sp) {
            if (2 * sp <= w) {
                float m[8];
#pragma unroll
                for (int half = 0; half < 2; ++half) { const int T = 2 * sp + half;
                    const float4 av = *(const float4*)(ach + T * 16 + 4 * g4), dv = *(const float4*)(dth + T * 16 + 4 * g4);
                    const float aa[4] = {av.x, av.y, av.z, av.w}, dd[4] = {dv.x, dv.y, dv.z, dv.w};
#pragma unroll
                    for (int q = 0; q < 4; ++q) { const int s = T * 16 + 4 * g4 + q; float mv = (s <= l) ? cbt[T][q] * __expf(al - aa[q]) * dd[q] : 0.f; if (s == l) mv += dsk; m[half * 4 + q] = mv; } }
                const bf16x8 pf = as_bf8(pack8u(m));
#pragma unroll
                for (int pt = 0; pt < 4; ++pt) { const bf16_t* vp = Xt + (pt * 16 + lr) * 136 + (2 * sp) * 16 + 4 * g4;
                    acc[pt] = mfma16(cat4(*(const bf16x4*)vp, *(const bf16x4*)(vp + 16)), pf, acc[pt]); }
            }
        }
        f32x4 off[4] = {F4ZERO, F4ZERO, F4ZERO, F4ZERO};
#pragma unroll
        for (int ks = 0; ks < 4; ++ks)
#pragma unroll
            for (int pt = 0; pt < 4; ++pt) off[pt] = mfma16(*(const bf16x8*)(Pv + (pt * 16 + lr) * 136 + ks * 32 + g4 * 8), cf[ks], off[pt]);
        const float ea = __expf(al);
#pragma unroll
        for (int pt = 0; pt < 4; ++pt) { const int col = hh * 64 + pt * 16 + 4 * g4;
            float z[4]; unpack4(zr[pt], z);
            float yv[4];
#pragma unroll
            for (int q = 0; q < 4; ++q) { yv[q] = (acc[pt][q] + off[pt][q] * ea) * silu_f(z[q]); ssq += yv[q] * yv[q]; }
            *(uint2*)(y + tok * DM + col) = pack4u(yv[0], yv[1], yv[2], yv[3]); }
    }
    ssq += __shfl_xor(ssq, 16); ssq += __shfl_xor(ssq, 32);
    const float scale = rsqrtf(ssq * (1.0f / 512.0f) + 1e-6f);
    const float* nw = p.ssd_norm + layer * 1024;
#pragma unroll 1
    for (int j = 0; j < 8; ++j)
#pragma unroll
        for (int pt = 0; pt < 4; ++pt) { const int col = (8 * g + j) * 64 + pt * 16 + 4 * g4;
            float yv[4]; unpack4(*(const uint2*)(y + tok * DM + col), yv); const float4 nv = *(const float4*)(nw + col);
            *(uint2*)(y + tok * DM + col) = pack4u(yv[0] * scale * nv.x, yv[1] * scale * nv.y, yv[2] * scale * nv.z, yv[3] * scale * nv.w); }
    __syncthreads();
}

__device__ __forceinline__ void ssd_out_item2(const Params& p, int layer, int idx, unsigned char* shm) {
    int tid0_ = threadIdx.x; asm volatile("" : "+v"(tid0_)); const int tid = tid0_, lane = tid & 63, w = __builtin_amdgcn_readfirstlane(tid >> 6), lr = lane & 15, g4 = lane >> 4;
    const int g = idx & 1, bc = idx >> 1, hh = 8 * g + w;
    const size_t tokbase = (size_t)bc * 128;
    float* cbt = (float*)shm;
    float* dts = (float*)(shm + 36864); float* acs = dts + 8 * 128;
    float* ssqp = (float*)(shm + 45056);
    bf16_t* Cs = (bf16_t*)(shm + 49152);
    bf16_t* Bs = Cs + 128 * 136;
    bf16_t* xt = Bs + w * (64 * 40);
    const bf16_t* proj = (const bf16_t*)(p.ws + OFF_PROJ); const bf16_t* xc = (const bf16_t*)(p.ws + OFF_XC);
    bf16_t* y = (bf16_t*)(p.ws + OFF_Y);
    { float d0, d1, a0, a1;
      (void)head_acum((const float*)(p.ws + OFF_DT), tokbase, hh, -__expf(p.a_log[layer * 16 + hh]), lane, d0, d1, a0, a1);
      dts[w * 128 + 2 * lane] = d0; dts[w * 128 + 2 * lane + 1] = d1; acs[w * 128 + 2 * lane] = a0; acs[w * 128 + 2 * lane + 1] = a1; }
    stage_nat<128>(xc + 1280 + g * 128, 1536, tokbase, Cs, 136, tid);
    stage_nat<128>(xc + 1024 + g * 128, 1536, tokbase, Bs, 136, tid);
    bf16x8 pv[4][4];
    { const bf16_t* ps = (const bf16_t*)(p.ws + OFF_SST) + ((size_t)bc * 16 + hh) * 8192 + lr * 128 + g4 * 8;
#pragma unroll
      for (int ks = 0; ks < 4; ++ks)
#pragma unroll
          for (int pt = 0; pt < 4; ++pt) pv[ks][pt] = *(const bf16x8*)(ps + pt * 16 * 128 + ks * 32); }
    uint4 xraw[4][4];
    { const int xr = lane >> 1, xh = lane & 1;
#pragma unroll
      for (int sp = 0; sp < 4; ++sp) { const bf16_t* src = xc + (tokbase + sp * 32 + xr) * 1536 + hh * 64 + xh * 32;
#pragma unroll
          for (int i = 0; i < 4; ++i) xraw[sp][i] = *(const uint4*)(src + 8 * i); } }
    __syncthreads();
    { int t = 0;
#pragma unroll
      for (int lt = 0; lt < 8; ++lt)
#pragma unroll
          for (int st = 0; st <= lt; ++st, ++t) {
              if ((t & 7) == w) { f32x4 c = F4ZERO;
#pragma unroll
                  for (int ks = 0; ks < 4; ++ks) c = mfma16(*(const bf16x8*)(Bs + (st * 16 + lr) * 136 + ks * 32 + g4 * 8), *(const bf16x8*)(Cs + (lt * 16 + lr) * 136 + ks * 32 + g4 * 8), c);
                  *(f32x4*)(cbt + (t * 64 + lane) * 4) = c; } } }
    __syncthreads();
    bf16x8 xf[4][4];
    { const int xr = lane >> 1, xh = lane & 1;
#pragma unroll
      for (int sp = 0; sp < 4; ++sp) {
#pragma unroll
          for (int i = 0; i < 4; ++i) { bf16_t* vp = xt + (xh * 32 + 8 * i) * 40 + xr; const uint4 r = xraw[sp][i];
              vp[0] = (bf16_t)(r.x & 0xffffu); vp[40] = (bf16_t)(r.x >> 16); vp[80] = (bf16_t)(r.y & 0xffffu); vp[120] = (bf16_t)(r.y >> 16);
              vp[160] = (bf16_t)(r.z & 0xffffu); vp[200] = (bf16_t)(r.z >> 16); vp[240] = (bf16_t)(r.w & 0xffffu); vp[280] = (bf16_t)(r.w >> 16); }
          __builtin_amdgcn_fence(__ATOMIC_RELEASE, "wavefront"); __builtin_amdgcn_wave_barrier(); __builtin_amdgcn_fence(__ATOMIC_ACQUIRE, "wavefront");
#pragma unroll
          for (int pt = 0; pt < 4; ++pt) { const bf16_t* vp = xt + (pt * 16 + lr) * 40 + 4 * g4; xf[sp][pt] = cat4(*(const bf16x4*)vp, *(const bf16x4*)(vp + 16)); }
          __builtin_amdgcn_fence(__ATOMIC_RELEASE, "wavefront"); __builtin_amdgcn_wave_barrier(); __builtin_amdgcn_fence(__ATOMIC_ACQUIRE, "wavefront");
      } }
    const float dsk = p.d_skip[layer * 16 + hh];
    const float* dth = dts + w * 128; const float* ach = acs + w * 128;
    uint2 zn[4];
#pragma unroll
    for (int pt = 0; pt < 4; ++pt) zn[pt] = *(const uint2*)(proj + (tokbase + lr) * LDP + hh * 64 + pt * 16 + 4 * g4);
#pragma unroll
    for (int lt = 0; lt < 8; ++lt) {
        const int l = lt * 16 + lr; const size_t tok = tokbase + l;
        uint2 zr[4];
#pragma unroll
        for (int pt = 0; pt < 4; ++pt) zr[pt] = zn[pt];
        if (lt < 7) {
#pragma unroll
            for (int pt = 0; pt < 4; ++pt) zn[pt] = *(const uint2*)(proj + (tok + 16) * LDP + hh * 64 + pt * 16 + 4 * g4); }
        bf16x8 cf[4];
#pragma unroll
        for (int ks = 0; ks < 4; ++ks) cf[ks] = *(const bf16x8*)(Cs + l * 136 + ks * 32 + g4 * 8);
        const float al = ach[l];
        f32x4 acc[4] = {F4ZERO, F4ZERO, F4ZERO, F4ZERO};
#pragma unroll
        for (int sp = 0; sp <= lt / 2; ++sp) {
            float m[8];
#pragma unroll
            for (int half = 0; half < 2; ++half) { const int T = 2 * sp + half;
                f32x4 cv = F4ZERO; if (T <= lt) cv = *(const f32x4*)(cbt + ((lt * (lt + 1) / 2 + T) * 64 + lane) * 4);
                const float4 av = *(const float4*)(ach + T * 16 + 4 * g4), dv = *(const float4*)(dth + T * 16 + 4 * g4);
                const float aa[4] = {av.x, av.y, av.z, av.w}, dd[4] = {dv.x, dv.y, dv.z, dv.w};
#pragma unroll
                for (int q = 0; q < 4; ++q) { float mv;
                    if (T < lt) mv = cv[q] * __expf(al - aa[q]) * dd[q];
                    else if (T == lt) { const int s = T * 16 + 4 * g4 + q; mv = (s <= l) ? cv[q] * __expf(al - aa[q]) * dd[q] : 0.f; if (s == l) mv += dsk; }
                    else mv = 0.f;
                    m[half * 4 + q] = mv; } }
            const bf16x8 pf = as_bf8(pack8u(m));
#pragma unroll
            for (int pt = 0; pt < 4; ++pt) acc[pt] = mfma16(xf[sp][pt], pf, acc[pt]);
        }
        f32x4 off[4] = {F4ZERO, F4ZERO, F4ZERO, F4ZERO};
#pragma unroll
        for (int ks = 0; ks < 4; ++ks)
#pragma unroll
            for (int pt = 0; pt < 4; ++pt) off[pt] = mfma16(pv[ks][pt], cf[ks], off[pt]);
        const float ea = __expf(al);
        float ssq = 0.f;
#pragma unroll
        for (int pt = 0; pt < 4; ++pt) { const int col = hh * 64 + pt * 16 + 4 * g4;
            float z[4]; unpack4(zr[pt], z);
            float yv[4];
#pragma unroll
            for (int q = 0; q < 4; ++q) { yv[q] = (acc[pt][q] + off[pt][q] * ea) * silu_f(z[q]); ssq += yv[q] * yv[q]; }
            *(uint2*)(y + tok * DM + col) = pack4u(yv[0], yv[1], yv[2], yv[3]); }
        ssq += __shfl_xor(ssq, 16); ssq += __shfl_xor(ssq, 32);
        if (g4 == 0) ssqp[w * 128 + l] = ssq;
    }
    __syncthreads();
    const float* nw = p.ssd_norm + layer * 1024;
#pragma unroll 4
    for (int lt = 0; lt < 8; ++lt) {
        const int l = lt * 16 + lr; const size_t tok = tokbase + l;
        float tot = 0.f;
#pragma unroll
        for (int k = 0; k < 8; ++k) tot += ssqp[k * 128 + l];
        const float scale = rsqrtf(tot * (1.0f / 512.0f) + 1e-6f);
#pragma unroll
        for (int pt = 0; pt < 4; ++pt) { const int col = hh * 64 + pt * 16 + 4 * g4;
            float yv[4]; unpack4(*(const uint2*)(y + tok * DM + col), yv); const float4 nv = *(const float4*)(nw + col);
            *(uint2*)(y + tok * DM + col) = pack4u(yv[0] * scale * nv.x, yv[1] * scale * nv.y, yv[2] * scale * nv.z, yv[3] * scale * nv.w); }
    }
    __syncthreads();
}

__device__ __forceinline__ void ret_out_item(const Params& p, int layer, int idx, unsigned char* shm) {
    int tid0_ = threadIdx.x; asm volatile("" : "+v"(tid0_)); const int tid = tid0_, lane = tid & 63, w = __builtin_amdgcn_readfirstlane(tid >> 6), lr = lane & 15, g4 = lane >> 4;
    const int h = idx & 3, bc = idx >> 2;
    const size_t tokbase = (size_t)bc * 128;
    bf16_t* Qs = (bf16_t*)shm; bf16_t* Ks = Qs + 128 * 72; bf16_t* Vt = Ks + 128 * 72; bf16_t* Pt = Vt + 128 * 136;
    const bf16_t* proj = (const bf16_t*)(p.ws + OFF_PROJ);
    const float lg2 = log1pf(-exp2f(-5.0f - (float)h)) * 1.4426950408889634f;
    uint2 gr[8];
#pragma unroll
    for (int et = 0; et < 8; ++et) gr[et] = *(const uint2*)(proj + (tokbase + w * 16 + lr) * LDP + PRG + h * 128 + et * 16 + 4 * g4);
    { const float* cosT = (const float*)(p.ws + OFF_ROPE); const float* sinT = cosT + 8192 * 32;
      const int sub = tid & 7, r0 = tid >> 3, t0 = (bc & 63) * 128;
      uint4 rq[2], rk[2];
#pragma unroll
      for (int it = 0; it < 2; ++it) { const bf16_t* src = proj + (tokbase + r0 + it * 64) * LDP + h * 64 + sub * 8; rq[it] = *(const uint4*)(src + PRQ); rk[it] = *(const uint4*)(src + PRK); }
#pragma unroll
      for (int it = 0; it < 2; ++it) { float v[8];
          unpack8(rq[it], v); rope8(v, cosT, sinT, t0 + r0 + it * 64, sub, 1.0f); *(uint4*)(Qs + (r0 + it * 64) * 72 + sub * 8) = pack8u(v);
          unpack8(rk[it], v); rope8(v, cosT, sinT, t0 + r0 + it * 64, sub, 0.125f); *(uint4*)(Ks + (r0 + it * 64) * 72 + sub * 8) = pack8u(v); } }
    stage_tr<128>(proj + PRV + h * 128, LDP, tokbase, Vt, 136, nullptr, tid);
    { const float* src = (const float*)(p.ws + OFF_RST) + ((size_t)bc * 4 + h) * 8192 + (tid >> 2) * 64 + (tid & 3) * 16;
      float v[16];
#pragma unroll
      for (int q = 0; q < 4; ++q) { const float4 f = *(const float4*)(src + 4 * q); v[4 * q] = f.x; v[4 * q + 1] = f.y; v[4 * q + 2] = f.z; v[4 * q + 3] = f.w; }
      bf16_t* dp = Pt + (tid >> 2) * 72 + (tid & 3) * 16;
      *(uint4*)dp = pack8u(v); *(uint4*)(dp + 8) = pack8u(v + 8); }
    __syncthreads();
    const int l = w * 16 + lr;
    bf16x8 qf[2];
#pragma unroll
    for (int ks = 0; ks < 2; ++ks) qf[ks] = *(const bf16x8*)(Qs + l * 72 + ks * 32 + g4 * 8);
    f32x4 o[8], cr[8];
#pragma unroll
    for (int et = 0; et < 8; ++et) { o[et] = F4ZERO; cr[et] = F4ZERO; }
#pragma unroll
    for (int sp = 0; sp < 4; ++sp) {
        if (2 * sp <= w) {
            float m[8];
#pragma unroll
            for (int half = 0; half < 2; ++half) { const int T = 2 * sp + half; f32x4 sc = F4ZERO;
                if (T <= w) {
#pragma unroll
                    for (int ks = 0; ks < 2; ++ks) sc = mfma16(*(const bf16x8*)(Ks + (T * 16 + lr) * 72 + ks * 32 + g4 * 8), qf[ks], sc); }
#pragma unroll
                for (int q = 0; q < 4; ++q) { const int s = T * 16 + 4 * g4 + q; const float e = sc[q] * __builtin_amdgcn_exp2f((float)(l - s) * lg2); m[half * 4 + q] = (T < w) ? e : ((s <= l) ? e : 0.f); } }
            const bf16x8 pf = as_bf8(pack8u(m));
#pragma unroll
            for (int et = 0; et < 8; ++et) { const bf16_t* vp = Vt + (et * 16 + lr) * 136 + (2 * sp) * 16 + 4 * g4;
                o[et] = mfma16(cat4(*(const bf16x4*)vp, *(const bf16x4*)(vp + 16)), pf, o[et]); }
        }
    }
#pragma unroll
    for (int ks = 0; ks < 2; ++ks)
#pragma unroll
        for (int et = 0; et < 8; ++et) cr[et] = mfma16(*(const bf16x8*)(Pt + (et * 16 + lr) * 72 + ks * 32 + g4 * 8), qf[ks], cr[et]);
    const float gl = __builtin_amdgcn_exp2f((float)(l + 1) * lg2);
    float ssq = 0.f;
#pragma unroll
    for (int et = 0; et < 8; ++et)
#pragma unroll
        for (int q = 0; q < 4; ++q) { o[et][q] += cr[et][q] * gl; ssq += o[et][q] * o[et][q]; }
    ssq += __shfl_xor(ssq, 16); ssq += __shfl_xor(ssq, 32);
    const float scale = rsqrtf(ssq * (1.0f / 128.0f) + 1e-6f);
    const size_t tok = tokbase + l;
    const float* nw = p.ret_norm + layer * 512;
    bf16_t* y = (bf16_t*)(p.ws + OFF_Y);
#pragma unroll
    for (int et = 0; et < 8; ++et) { const int col = h * 128 + et * 16 + 4 * g4;
        float gt[4]; unpack4(gr[et], gt); const float4 nv = *(const float4*)(nw + col);
        *(uint2*)(y + tok * DM + 1536 + col) = pack4u(o[et][0] * scale * nv.x * silu_f(gt[0]), o[et][1] * scale * nv.y * silu_f(gt[1]), o[et][2] * scale * nv.z * silu_f(gt[2]), o[et][3] * scale * nv.w * silu_f(gt[3])); }
    __syncthreads();
}

#define KA __attribute__((address_space(4)))
__device__ __forceinline__ Params ld_params() {
    const KA Params* pp = (const KA Params*)__builtin_amdgcn_kernarg_segment_ptr();
    asm volatile("" : "+s"(pp));
    Params q; q.x = pp->x; q.ln_mix = pp->ln_mix; q.w_in = pp->w_in; q.conv_w = pp->conv_w; q.conv_b = pp->conv_b; q.dt_bias = pp->dt_bias; q.a_log = pp->a_log; q.d_skip = pp->d_skip; q.ssd_norm = pp->ssd_norm;
    q.q_norm = pp->q_norm; q.k_norm = pp->k_norm; q.ret_norm = pp->ret_norm; q.w_out = pp->w_out; q.ln_ffn = pp->ln_ffn; q.w_gate = pp->w_gate; q.w_up = pp->w_up; q.w_down = pp->w_down; q.out = pp->out; q.ws = pp->ws;
    return q;
}
#ifndef PROBE_MASK
#define PROBE_MASK 0
#endif
#ifndef PROBE_K
#define PROBE_K 2
#endif
#define TICK(id) do { if (PROBE_MASK & (1 << (id))) pt0 = __builtin_amdgcn_s_memrealtime(); } while (0)
#define TOCK(id) do { if (PROBE_MASK & (1 << (id))) pacc += __builtin_amdgcn_s_memrealtime() - pt0; } while (0)
__global__ __launch_bounds__(512, 2) void hybrid_fwd(Params p_unused) {
    extern __shared__ __attribute__((aligned(16))) unsigned char shm[];
    cg::grid_group grid = cg::this_grid();
    unsigned long long pt0 = 0, pacc = 0; (void)pt0;
    volatile XLAS unsigned* bst = (volatile XLAS unsigned*)(shm + 131072);
    if (threadIdx.x == 0) { bst[0] = 0u; bst[1] = 0u; }
    __syncthreads();
    const XcdBarrier xb = xcd_barrier_post((unsigned*)(ld_params().ws + OFF_BAR), bst);
    if (threadIdx.x == 0) bst[2] = xb_add((unsigned*)(ld_params().ws + OFF_BAR) + 16 + xb.x, 1u);
#define GSYNC() xcd_barrier(xb)
    if ((PROBE_MASK & (1 << 13)) && threadIdx.x == 0 && xb.x != (blockIdx.x & 7u)) atomicAdd((unsigned*)(ld_params().ws + OFF_BAR), 1u);
    { const Params p = ld_params(); phase_prep(p, shm); }
    { const Params p = ld_params(); phase_resid<true, true>(p.x, (bf16_t*)(p.ws + OFF_HN), nullptr, (bf16_t*)(p.ws + OFF_Y), p.ln_mix, p.w_in, p.dt_bias, (float*)(p.ws + OFF_DT), shm); }
    grid.sync();
    if (threadIdx.x == 0) { unsigned* bar = (unsigned*)(ld_params().ws + OFF_BAR); bool uni = (gridDim.x & 7u) == 0u;
        for (unsigned j = 0; j < 16; ++j) { const unsigned c = xb_ld(&bar[XB_XCNT(j)]); uni = uni && (c == (j < 8 ? gridDim.x / 8u : 0u)); }
        bst[3] = uni ? (bst[2] * 8u + xb.x) : blockIdx.x; }
    __syncthreads();
    const int vb = (int)bst[3];
    if ((PROBE_MASK & (1 << 14)) && threadIdx.x == 0 && vb != (int)blockIdx.x) atomicAdd((unsigned*)(ld_params().ws + OFF_BAR) + 1, 1u);
#pragma unroll 1
    for (int layer = 0; layer < 2; ++layer) {
        if (layer > 0) {
            TICK(1);
            { const Params p = ld_params(); phase_resid<true, false>(nullptr, (bf16_t*)(p.ws + OFF_HN), nullptr, (bf16_t*)(p.ws + OFF_Y), p.ln_mix + layer * DM, p.w_in + (size_t)layer * DM * INW, p.dt_bias + layer * 16, (float*)(p.ws + OFF_DT), shm); }
            GSYNC();
            TOCK(1);
        }
        TICK(2);
        { const Params p = ld_params(); pg8::EpiProj E; E.O = (bf16_t*)(p.ws + OFF_PROJ); E.ldc = LDP; E.rs = nullptr; run_gemm(shm, (const bf16_t*)(p.ws + OFF_Y), (const bf16_t*)(p.ws + OFF_WIN + layer * SZ_WIN), NTOK, 5632, DM, E, vb); }
        GSYNC();
        TOCK(2);
        TICK(3);
        { const Params p = ld_params(); phase_pre(p, layer); }
        GSYNC();
        TOCK(3);
        TICK(4);
        { const Params p = ld_params(); const int per = (6144 + (int)gridDim.x - 1) / (int)gridDim.x, u0 = (int)blockIdx.x * per; int cnt = 6144 - u0; cnt = cnt < per ? cnt : per;
          att_run(p, u0, cnt, shm); }
        { const Params p = ld_params();
          for (int it = blockIdx.x; it < 1536; it += gridDim.x) {
            if (it < 512) ssd_state_item(p, layer, it, shm);
            else ret_state_item(p, it - 512, shm);
          } }
        GSYNC();
        TOCK(4);
        TICK(5);
        { const Params p = ld_params(); phase_scan(p); }
        GSYNC();
        TOCK(5);
        TICK(6);
        { const Params p = ld_params();
          for (int it = blockIdx.x; it < 1536; it += gridDim.x) {
            if (it < 512) { for (int rep = 0; rep < REP_SO; ++rep) SSD_OUT(p, layer, it, shm); }
            else { for (int rep = 0; rep < REP_RO; ++rep) ret_out_item(p, layer, it - 512, shm); }
          } }
        GSYNC();
        TOCK(6);
        TICK(7);
        { const Params p = ld_params(); pg8::EpiAccB E; E.X = (bf16_t*)(p.ws + OFF_HN); E.ldc = DM; run_gemm(shm, (const bf16_t*)(p.ws + OFF_Y), (const bf16_t*)(p.ws + OFF_WOUT + layer * SZ_WOUT), NTOK, DM, DM, E, vb); }
        GSYNC();
        TOCK(7);
        TICK(8);
        { const Params p = ld_params();
          phase_resid<false, false>(nullptr, (bf16_t*)(p.ws + OFF_HN), nullptr, (bf16_t*)(p.ws + OFF_Y), nullptr, nullptr, nullptr, nullptr, shm); }
        GSYNC();
        TOCK(8);
        TICK(9);
        unsigned long long pc0 = 0, pr0 = 0; if (PROBE_MASK & (1 << 15)) { pc0 = clock64(); pr0 = __builtin_amdgcn_s_memrealtime(); }
        { const Params p = ld_params(); pg8::EpiSwiGLU E; E.H = (bf16_t*)(p.ws + OFF_PROJ); E.ldc = DFF; E.rs = nullptr; run_gemm(shm, (const bf16_t*)(p.ws + OFF_Y), (const bf16_t*)(p.ws + OFF_WGU + layer * SZ_WGU), NTOK, 2 * DFF, DM, E, vb, &pacc); }
        if (PROBE_MASK & (1 << 15)) { const unsigned long long dc = clock64() - pc0, dr = __builtin_amdgcn_s_memrealtime() - pr0; pacc = (layer == 1) ? (dc * 100ull / dr) * 50ull : 0ull; }
        GSYNC();
        TOCK(9);
        TICK(10);
        if (layer == 0) { const Params p = ld_params(); pg8::EpiAccB E; E.X = (bf16_t*)(p.ws + OFF_HN); E.ldc = DM; run_gemm(shm, (const bf16_t*)(p.ws + OFF_PROJ), (const bf16_t*)(p.ws + OFF_WDN + layer * SZ_WDN), NTOK, DM, DFF, E, vb); GSYNC(); }
        else { const Params p = ld_params(); pg8::EpiRes E; E.C = p.out; E.R = (const bf16_t*)(p.ws + OFF_HN); E.ldc = DM; run_gemm(shm, (const bf16_t*)(p.ws + OFF_PROJ), (const bf16_t*)(p.ws + OFF_WDN + layer * SZ_WDN), NTOK, DM, DFF, E, vb); }
        TOCK(10);
    }
    if ((PROBE_MASK & (1 << 13)) && blockIdx.x == 0 && threadIdx.x == 0) pacc = 1000ull * __hip_atomic_load((unsigned*)(ld_params().ws + OFF_BAR), __ATOMIC_RELAXED, __HIP_MEMORY_SCOPE_AGENT);
    if ((PROBE_MASK & (1 << 14)) && blockIdx.x == 0 && threadIdx.x == 0) pacc = 1000ull * __hip_atomic_load((unsigned*)(ld_params().ws + OFF_BAR) + 1, __ATOMIC_RELAXED, __HIP_MEMORY_SCOPE_AGENT);
    if (PROBE_MASK && blockIdx.x == 0 && threadIdx.x == 0) { const unsigned long long ts = __builtin_amdgcn_s_memrealtime(); while (__builtin_amdgcn_s_memrealtime() - ts < (unsigned long long)PROBE_K * pacc) __builtin_amdgcn_s_sleep(8); }
}

extern "C" void kernel_launch(void* const* d_in, const int* in_sizes, int n_in, void* d_out, int out_size, void* d_ws, size_t ws_size, hipStream_t stream) {
    static int grid = 0;
    if (grid == 0) {
        if (n_in != 17 || ws_size < WS_END) { fprintf(stderr, "kernel_launch: unexpected n_in %d / ws_size %zu (need %zu)\n", n_in, ws_size, (size_t)WS_END); grid = -1; return; }
        int dev = 0, cus = 0, per_cu = 0;
        (void)hipGetDevice(&dev); (void)hipDeviceGetAttribute(&cus, hipDeviceAttributeMultiprocessorCount, dev);
        if (hipFuncSetAttribute((const void*)hybrid_fwd, hipFuncAttributeMaxDynamicSharedMemorySize, LDS_BYTES) != hipSuccess) { fprintf(stderr, "kernel_launch: hipFuncSetAttribute failed\n"); grid = -1; return; }
        if (hipOccupancyMaxActiveBlocksPerMultiprocessor(&per_cu, (const void*)hybrid_fwd, 512, LDS_BYTES) != hipSuccess || per_cu < 1) { fprintf(stderr, "kernel_launch: occupancy query says %d\n", per_cu); per_cu = 1; }
        (void)hipGetLastError();
        grid = cus * per_cu;
    }
    if (grid < 0) return;
    Params p{};
    const float** f = (const float**)&p;
    for (int i = 0; i < 17; ++i) f[i] = (const float*)d_in[i];
    p.out = (float*)d_out; p.ws = (unsigned char*)d_ws;
    if (hipMemsetAsync((unsigned char*)d_ws + OFF_BAR, 0, (size_t)XCD_BAR_WORDS * 4, stream) != hipSuccess) { fprintf(stderr, "kernel_launch: memset of the barrier words failed\n"); return; }
    void* args[] = {&p};
    const hipError_t e = hipLaunchCooperativeKernel((const void*)hybrid_fwd, dim3(grid), dim3(512), args, LDS_BYTES, stream);
    if (e != hipSuccess) fprintf(stderr, "kernel_launch: cooperative launch failed: %s (grid %d)\n", hipGetErrorString(e), grid);
}
```

```cpp
#include <hip/hip_runtime.h>
#include <hip/hip_cooperative_groups.h>
#include <cstdio>
namespace cg = cooperative_groups;
#ifndef PROBE_MASK
#define PROBE_MASK 0
#endif
#ifndef PROBE_K
#define PROBE_K 2
#endif
#ifndef PROBE_GEMM
#define PROBE_GEMM 9
#endif
#ifndef REP_SO
#define REP_SO 1
#endif
#ifndef REP_RO
#define REP_RO 1
#endif
#ifndef SSD_OUT
#define SSD_OUT ssd_out_item2
#endif
#include <cstdint>
#define XB_TMO      128
#define XB_XCNT(j)  (256  + 64 * (j))
#define XB_XSUB(j)  (1280 + 64 * (j))
#define XB_XGEN(j)  (2304 + 64 * (j))
#define XB_TOP      3328
#define XB_TOPGEN   3392
#define XCD_BAR_WORDS 3456
#define XB_SPIN_CAP (1u << 18)
#define XLAS __attribute__((address_space(3)))

__device__ __forceinline__ unsigned xb_ld(unsigned* p)              { return __hip_atomic_load(p, __ATOMIC_RELAXED, __HIP_MEMORY_SCOPE_AGENT); }
__device__ __forceinline__ unsigned xb_add(unsigned* p, unsigned v) { return __hip_atomic_fetch_add(p, v, __ATOMIC_RELAXED, __HIP_MEMORY_SCOPE_AGENT); }
__device__ __forceinline__ unsigned xb_xcc_id() { return (unsigned)__builtin_amdgcn_s_getreg((3 << 11) | 20) & 0xFu; }
#define XB_SPIN(cond, bar) do { unsigned _sp = 0; while (cond) {   \
    if ((++_sp & 255u) == 0u) { if (xb_ld(&(bar)[XB_TMO])) break; if (_sp > XB_SPIN_CAP) { atomicAdd(&(bar)[XB_TMO], 1u); break; } } } } while (0)

struct XcdBarrier {
    unsigned* bar; unsigned x;
    volatile XLAS unsigned* st;
};

__device__ __forceinline__ XcdBarrier xcd_barrier_post(unsigned* bar, volatile XLAS unsigned* st) {
    XcdBarrier b; b.bar = bar; b.x = xb_xcc_id(); b.st = st;
    if (threadIdx.x == 0) (void)xb_add(&bar[XB_XCNT(b.x)], 1u);
    return b;
}
__device__ __forceinline__ void xcd_barrier_complete(unsigned* bar, unsigned x, unsigned& nloc, unsigned& nx) {
    const unsigned G = gridDim.x * gridDim.y * gridDim.z;
    unsigned sum, cnt, mine, sp = 0u;
    for (;;) {
        sum = 0u; cnt = 0u; mine = 0u;
#pragma unroll
        for (unsigned j = 0; j < 16; ++j) { const unsigned c = xb_ld(&bar[XB_XCNT(j)]); sum += c; cnt += (c > 0u) ? 1u : 0u; mine = (j == x) ? c : mine; }
        if (sum == G) break;
        __builtin_amdgcn_s_sleep(1);
        if ((++sp & 255u) == 0u) { if (xb_ld(&bar[XB_TMO])) break; if (sp > XB_SPIN_CAP) { atomicAdd(&bar[XB_TMO], 1u); break; } }
    }
    nloc = mine > 0u ? mine : 1u; nx = cnt > 0u ? cnt : 1u;
}

__device__ __forceinline__ void xcd_barrier(const XcdBarrier& b) {
    asm volatile("s_waitcnt vmcnt(0)" ::: "memory");
    __syncthreads();
    if (threadIdx.x == 0) {
        unsigned* bar = b.bar;
        __builtin_amdgcn_s_waitcnt(0);
        unsigned nloc = b.st[0], nx = b.st[1];
        if (nloc == 0u) { xcd_barrier_complete(bar, b.x, nloc, nx); b.st[0] = nloc; b.st[1] = nx; }
        const unsigned old = xb_add(&bar[XB_XSUB(b.x)], 1u);
        const unsigned gen = old / nloc;
        if (old + 1u == (gen + 1u) * nloc) {
            __builtin_amdgcn_fence(__ATOMIC_RELEASE, "agent");
            asm volatile("s_waitcnt vmcnt(0)" ::: "memory");
            const unsigned og = xb_add(&bar[XB_TOP], 1u);
            const unsigned tg = og / nx;
            if (og + 1u == (tg + 1u) * nx) xb_add(&bar[XB_TOPGEN], 1u);
            else XB_SPIN(xb_ld(&bar[XB_TOPGEN]) == tg, bar);
            __builtin_amdgcn_fence(__ATOMIC_ACQUIRE, "agent");
            xb_add(&bar[XB_XGEN(b.x)], 1u);
            asm volatile("s_waitcnt vmcnt(0)" ::: "memory");
        } else {
            XB_SPIN(xb_ld(&bar[XB_XGEN(b.x)]) == gen, bar);
            __builtin_amdgcn_fence(__ATOMIC_ACQUIRE, "agent");
            asm volatile("s_waitcnt vmcnt(0)" ::: "memory");
        }
    }
    __syncthreads();
}

namespace pg8 {
#define PG8_LAS __attribute__((address_space(3)))
typedef unsigned short bf16_t;
typedef short bf16x8 __attribute__((ext_vector_type(8)));
typedef float f32x4 __attribute__((ext_vector_type(4)));
typedef unsigned u32x4 __attribute__((ext_vector_type(4)));
constexpr int BM = 256, BK = 64, HALF = 128, HTB = HALF * BK * 2  , STAGE_BYTES = 8 * HTB, NXCD = 8, WGM = 8;

__host__ __device__ __forceinline__ int lds_byte(int r, int c) { const int st = (r >> 4) * 2 + (c >> 5), rr = r & 15, cc = c & 31, ob = rr * 64 + cc * 2; return st * 1024 + (ob ^ (((ob >> 9) & 1) << 5)); }
__host__ __device__ __forceinline__ void stage_rc(int b, int& R, int& C) { const int st = b / 1024, sb = b % 1024, swz = sb ^ (((sb >> 9) & 1) << 5); R = (st >> 1) * 16 + swz / 64; C = (st & 1) * 32 + (swz % 64) / 2; }
__host__ __device__ __forceinline__ int perm32(int rho) { const int n = rho >> 4, i = rho & 15; return 8 * (i >> 2) + 4 * n + (i & 3); }

struct Unit { int pm, pn; };
struct Gemm { const bf16_t* A; const bf16_t* Bt; int M, N, K; };

struct StaticOrder {
    int nM, nN, nwg, G, c;
    __host__ __device__ void init(int M, int N, int G_, int c_) { nM = M / BM; nN = N / BM; nwg = nM * nN; G = G_; c = c_; }
    __host__ __device__ bool next(int i, Unit& u) const {
        const long L = (long)i * G + c; if (L >= nwg) return false;
        int wgid = (int)L; { const int q = nwg / NXCD, r = nwg % NXCD, xcd = wgid % NXCD, off = wgid / NXCD; wgid = (xcd < r ? xcd * (q + 1) : r * (q + 1) + (xcd - r) * q) + off; }
        const int nig = WGM * nN, gid = wgid / nig, fm = gid * WGM, gsz = (nM - fm) < WGM ? (nM - fm) : WGM;
        u.pm = fm + ((wgid % nig) % gsz); u.pn = (wgid % nig) / gsz; return true;
    }
    __device__ __forceinline__ void a_ready(const Unit&) const {}
    __device__ __forceinline__ void done(const Unit&) const {}
};
__device__ __forceinline__ unsigned cvt_pk_bf16(float lo, float hi) { unsigned r; asm volatile("v_cvt_pk_bf16_f32 %0, %1, %2" : "=v"(r) : "v"(lo), "v"(hi)); return r; }
struct EpiProj {
    static constexpr bool PERM = true, AFTER_DRAIN = false;
    bf16_t* O; int ldc; const float* rs;
    __device__ __forceinline__ void operator()(const f32x4 (&acc)[2][2][4][2], const Unit& u, int wr, int wc, int fr, int fq) const {
        const int row0 = u.pm * BM + wr * 64 + fr, col0 = u.pn * BM + wc * 32 + 8 * fq;
#pragma unroll
        for (int ai = 0; ai < 2; ++ai)
#pragma unroll
            for (int m = 0; m < 4; ++m) { bf16_t* rowp = O + (size_t)(row0 + ai * HALF + m * 16) * ldc + col0; const float sc = rs ? rs[row0 + ai * HALF + m * 16] : 1.0f;
#pragma unroll
                for (int bj = 0; bj < 2; ++bj) { const f32x4 v0 = acc[ai][bj][m][0] * sc, v1 = acc[ai][bj][m][1] * sc;
                    u32x4 w; w.x = cvt_pk_bf16(v0[0], v0[1]); w.y = cvt_pk_bf16(v0[2], v0[3]); w.z = cvt_pk_bf16(v1[0], v1[1]); w.w = cvt_pk_bf16(v1[2], v1[3]);
                    *(u32x4*)(rowp + bj * HALF) = w; } }
    }
};
struct EpiRes {
    static constexpr bool PERM = false, AFTER_DRAIN = false;
    float* C; const bf16_t* R; int ldc;
    __device__ __forceinline__ void operator()(const f32x4 (&acc)[2][2][4][2], const Unit& u, int wr, int wc, int fr, int fq) const {
        const int row0 = u.pm * BM + wr * 64 + fr, col0 = u.pn * BM + wc * 32 + 4 * fq;
#pragma unroll
        for (int ai = 0; ai < 2; ++ai)
#pragma unroll
            for (int m = 0; m < 4; ++m) { const size_t ro = (size_t)(row0 + ai * HALF + m * 16) * ldc + col0;
#pragma unroll
                for (int bj = 0; bj < 2; ++bj)
#pragma unroll
                    for (int n = 0; n < 2; ++n) { const uint2 rw = *(const uint2*)(R + ro + bj * HALF + n * 16);
                        f32x4 r; r[0] = __uint_as_float(rw.x << 16); r[1] = __uint_as_float(rw.x & 0xffff0000u); r[2] = __uint_as_float(rw.y << 16); r[3] = __uint_as_float(rw.y & 0xffff0000u);
                        *(f32x4*)(C + ro + bj * HALF + n * 16) = acc[ai][bj][m][n] + r; } }
    }
};
__device__ __forceinline__ float silu_f(float v) { return v * __builtin_amdgcn_rcpf(1.0f + __expf(-v)); }
struct EpiSwiGLU {
    static constexpr bool PERM = true, AFTER_DRAIN = false;
    bf16_t* H; int ldc; const float* rs;
    __device__ __forceinline__ void operator()(const f32x4 (&acc)[2][2][4][2], const Unit& u, int wr, int wc, int fr, int fq) const {
        const int row0 = u.pm * BM + wr * 64 + fr, col0 = u.pn * HALF + wc * 32 + 8 * fq;
#pragma unroll
        for (int ai = 0; ai < 2; ++ai)
#pragma unroll
            for (int m = 0; m < 4; ++m) { bf16_t* rowp = H + (size_t)(row0 + ai * HALF + m * 16) * ldc + col0; const float sc = rs ? rs[row0 + ai * HALF + m * 16] : 1.0f;
                f32x4 v0, v1;
#pragma unroll
                for (int j = 0; j < 4; ++j) { v0[j] = silu_f(acc[ai][0][m][0][j] * sc) * (acc[ai][1][m][0][j] * sc); v1[j] = silu_f(acc[ai][0][m][1][j] * sc) * (acc[ai][1][m][1][j] * sc); }
                u32x4 w; w.x = cvt_pk_bf16(v0[0], v0[1]); w.y = cvt_pk_bf16(v0[2], v0[3]); w.z = cvt_pk_bf16(v1[0], v1[1]); w.w = cvt_pk_bf16(v1[2], v1[3]);
                *(u32x4*)rowp = w; }
    }
};
struct EpiAccB {
    static constexpr bool PERM = true, AFTER_DRAIN = false;
    bf16_t* X; int ldc;
    __device__ __forceinline__ void operator()(const f32x4 (&acc)[2][2][4][2], const Unit& u, int wr, int wc, int fr, int fq) const {
        const int row0 = u.pm * BM + wr * 64 + fr, col0 = u.pn * BM + wc * 32 + 8 * fq;
#pragma unroll
        for (int ai = 0; ai < 2; ++ai) {
            u32x4 old[4][2];
#pragma unroll
            for (int m = 0; m < 4; ++m)
#pragma unroll
                for (int bj = 0; bj < 2; ++bj) old[m][bj] = *(const u32x4*)(X + (size_t)(row0 + ai * HALF + m * 16) * ldc + col0 + bj * HALF);
#pragma unroll
            for (int m = 0; m < 4; ++m)
#pragma unroll
                for (int bj = 0; bj < 2; ++bj) { const f32x4 v0 = acc[ai][bj][m][0], v1 = acc[ai][bj][m][1]; const u32x4 o = old[m][bj];
                    u32x4 w;
                    w.x = cvt_pk_bf16(v0[0] + __uint_as_float(o.x << 16), v0[1] + __uint_as_float(o.x & 0xffff0000u)); w.y = cvt_pk_bf16(v0[2] + __uint_as_float(o.y << 16), v0[3] + __uint_as_float(o.y & 0xffff0000u));
                    w.z = cvt_pk_bf16(v1[0] + __uint_as_float(o.z << 16), v1[1] + __uint_as_float(o.z & 0xffff0000u)); w.w = cvt_pk_bf16(v1[2] + __uint_as_float(o.w << 16), v1[3] + __uint_as_float(o.w & 0xffff0000u));
                    *(u32x4*)(X + (size_t)(row0 + ai * HALF + m * 16) * ldc + col0 + bj * HALF) = w; }
        }
    }
};
template <class Epi, class Sched, bool ALIGN_EPI = false, bool SP2 = false>
__device__ __forceinline__ void gemm_phase(PG8_LAS unsigned char* lds, const Gemm g, const Sched& S, const Epi& E) {
    int tid0_ = threadIdx.x; asm volatile("" : "+v"(tid0_)); const int tid = tid0_, wid = __builtin_amdgcn_readfirstlane(tid >> 6), lane = tid & 63, wr = wid >> 2, wc = wid & 3, fr = lane & 15, fq = lane >> 4;
    const int K = g.K, nt = K / BK;
    unsigned voffA[2], voffB[2];
#pragma unroll
    for (int i = 0; i < 2; ++i) { int R, C; stage_rc(tid * 16 + i * 8192, R, C); const int Rb = Epi::PERM ? ((R & ~31) + perm32(R & 31)) : R;
        voffA[i] = (unsigned)(R * K + C) * 2u; voffB[i] = (unsigned)(Rb * K + C) * 2u; }
    const size_t kstep = (size_t)(BK * 2);
    const size_t hstep = (size_t)HALF * K * 2;
    const size_t tstep = 2 * hstep;
    const unsigned ldsw = (unsigned)wid * 1024u;
    const int aoff = lds_byte(wr * 64 + fr, fq * 8), boff = lds_byte(wc * 32 + fr, fq * 8);
#define PG8_SA(b, h) (((b) * 2 + (h)) * HTB)
#define PG8_SB(b, h) ((4 + (b) * 2 + (h)) * HTB)
#define PG8_STAGE(bufoff, gbase, voff) do { _Pragma("unroll") for (int _i = 0; _i < 2; ++_i) \
        __builtin_amdgcn_global_load_lds((const unsigned*)((const char*)(gbase) + (voff)[_i]), (PG8_LAS unsigned*)(lds + (bufoff) + ldsw + _i * 8192), 16, 0, 0); } while (0)
#define PG8_LDA(dst, b, h) do { _Pragma("unroll") for (int m = 0; m < 4; ++m) _Pragma("unroll") for (int k = 0; k < 2; ++k) dst[m][k] = *(const PG8_LAS bf16x8*)(lds + PG8_SA(b, h) + aoff + m * 2048 + k * 1024); } while (0)
#define PG8_LDB(dst, b, h) do { _Pragma("unroll") for (int n = 0; n < 2; ++n) _Pragma("unroll") for (int k = 0; k < 2; ++k) dst[n][k] = *(const PG8_LAS bf16x8*)(lds + PG8_SB(b, h) + boff + n * 2048 + k * 1024); } while (0)
#define PG8_MMA(ai, bj, At, Bt) do { __builtin_amdgcn_s_setprio(1); _Pragma("unroll") for (int m = 0; m < 4; ++m) _Pragma("unroll") for (int n = 0; n < 2; ++n) _Pragma("unroll") for (int k = 0; k < 2; ++k) \
        acc[ai][bj][m][n] = __builtin_amdgcn_mfma_f32_16x16x32_bf16(Bt[n][k], At[m][k], acc[ai][bj][m][n], 0, 0, 0); __builtin_amdgcn_s_setprio(0); } while (0)
#define PG8_WAIT_V(n) asm volatile("s_waitcnt vmcnt(" #n ")" ::: "memory")
#define PG8_WAIT_L(n) asm volatile("s_waitcnt lgkmcnt(" #n ")" ::: "memory")
#define PG8_BAR __builtin_amdgcn_s_barrier()
#define PG8_SCHED __builtin_amdgcn_sched_barrier(0)
    Unit cur, nxt; int ui = 0;
    if (!S.next(0, cur)) return;
    f32x4 acc[2][2][4][2];
#pragma unroll
    for (int a = 0; a < 2; ++a)
#pragma unroll
        for (int b = 0; b < 2; ++b)
#pragma unroll
            for (int m = 0; m < 4; ++m)
#pragma unroll
                for (int n = 0; n < 2; ++n) acc[a][b][m][n] = (f32x4){0.f, 0.f, 0.f, 0.f};
    bf16x8 At[4][2], B0[2][2], B1[2][2];
    const char* cA = (const char*)g.A + (size_t)cur.pm * tstep; const char* cB = (const char*)g.Bt + (size_t)cur.pn * tstep;
    S.a_ready(cur);
    if constexpr (SP2) {
        PG8_STAGE(PG8_SB(0, 0), cB, voffB); PG8_STAGE(PG8_SB(0, 1), cB + hstep, voffB); PG8_STAGE(PG8_SA(0, 0), cA, voffA); PG8_STAGE(PG8_SA(0, 1), cA + hstep, voffA);
        if (wr == 1) PG8_BAR;
        PG8_WAIT_V(2); PG8_BAR;
        PG8_STAGE(PG8_SB(1, 0), cB + kstep, voffB); PG8_STAGE(PG8_SA(1, 0), cA + kstep, voffA); PG8_STAGE(PG8_SB(1, 1), cB + hstep + kstep, voffB);
        PG8_WAIT_V(6); PG8_BAR;
    } else {
        PG8_STAGE(PG8_SB(0, 0), cB, voffB); PG8_STAGE(PG8_SA(0, 0), cA, voffA); PG8_STAGE(PG8_SB(0, 1), cB + hstep, voffB); PG8_STAGE(PG8_SA(0, 1), cA + hstep, voffA);
        if (wr == 1) PG8_BAR;
        PG8_WAIT_V(4); PG8_BAR;
        PG8_STAGE(PG8_SB(1, 0), cB + kstep, voffB); PG8_STAGE(PG8_SA(1, 0), cA + kstep, voffA); PG8_STAGE(PG8_SB(1, 1), cB + hstep + kstep, voffB);
        PG8_WAIT_V(6); PG8_BAR;
    }
    for (;;) {
        const bool has_next = S.next(ui + 1, nxt);
        const char* nA = has_next ? (const char*)g.A + (size_t)nxt.pm * tstep : cA; const char* nB = has_next ? (const char*)g.Bt + (size_t)nxt.pn * tstep : cB;
        for (int t = 0; t < nt; t += 2) {
            const bool last = (t == nt - 2);
            const char* a1 = cA + (size_t)(t + 1) * kstep;
            const char* a2 = last ? nA : cA + (size_t)(t + 2) * kstep; const char* b2 = last ? nB : cB + (size_t)(t + 2) * kstep;
            const char* a3 = a2 + kstep; const char* b3 = b2 + kstep;
            if (last && has_next) S.a_ready(nxt);
            if constexpr (SP2) {
            PG8_LDB(B0, 0, 0); PG8_LDB(B1, 0, 1); PG8_SCHED; PG8_LDA(At, 0, 0); PG8_STAGE(PG8_SA(1, 1), a1 + hstep, voffA);
            PG8_WAIT_V(8); PG8_WAIT_L(0); PG8_BAR; PG8_MMA(0, 0, At, B0); PG8_MMA(0, 1, At, B1); PG8_BAR; PG8_SCHED;
            PG8_LDA(At, 0, 1); PG8_STAGE(PG8_SB(0, 0), b2, voffB); PG8_STAGE(PG8_SB(0, 1), b2 + hstep, voffB); PG8_STAGE(PG8_SA(0, 0), a2, voffA);
            PG8_WAIT_V(8); PG8_WAIT_L(0); PG8_BAR; PG8_MMA(1, 0, At, B0); PG8_MMA(1, 1, At, B1); PG8_BAR; PG8_SCHED;
            PG8_LDB(B0, 1, 0); PG8_LDB(B1, 1, 1); PG8_SCHED; PG8_LDA(At, 1, 0); PG8_STAGE(PG8_SA(0, 1), a2 + hstep, voffA);
            PG8_WAIT_V(8); PG8_WAIT_L(0); PG8_BAR; PG8_MMA(0, 0, At, B0); PG8_MMA(0, 1, At, B1); PG8_BAR; PG8_SCHED;
            PG8_LDA(At, 1, 1); PG8_STAGE(PG8_SB(1, 0), b3, voffB); PG8_STAGE(PG8_SB(1, 1), b3 + hstep, voffB); PG8_STAGE(PG8_SA(1, 0), a3, voffA);
            PG8_WAIT_V(8); PG8_WAIT_L(0); PG8_BAR; PG8_MMA(1, 0, At, B0); PG8_MMA(1, 1, At, B1); PG8_BAR; PG8_SCHED;
            } else {
            PG8_LDB(B0, 0, 0); PG8_SCHED; PG8_LDA(At, 0, 0); PG8_STAGE(PG8_SA(1, 1), a1 + hstep, voffA);
            PG8_WAIT_L(8); PG8_BAR; PG8_WAIT_L(0); PG8_MMA(0, 0, At, B0); PG8_BAR; PG8_SCHED;
            PG8_LDB(B1, 0, 1); PG8_STAGE(PG8_SB(0, 0), b2, voffB);
            PG8_BAR; PG8_WAIT_L(0); PG8_MMA(0, 1, At, B1); PG8_BAR;
            PG8_LDA(At, 0, 1); PG8_STAGE(PG8_SA(0, 0), a2, voffA);
            PG8_BAR; PG8_WAIT_L(0); PG8_MMA(1, 0, At, B0); PG8_BAR; PG8_SCHED;
            PG8_STAGE(PG8_SB(0, 1), b2 + hstep, voffB);
            PG8_WAIT_V(6); PG8_BAR; PG8_MMA(1, 1, At, B1); PG8_BAR;
            PG8_LDB(B0, 1, 0); PG8_SCHED; PG8_LDA(At, 1, 0); PG8_STAGE(PG8_SA(0, 1), a2 + hstep, voffA);
            PG8_WAIT_L(8); PG8_BAR; PG8_WAIT_L(0); PG8_MMA(0, 0, At, B0); PG8_BAR; PG8_SCHED;
            PG8_LDB(B1, 1, 1); PG8_STAGE(PG8_SB(1, 0), b3, voffB);
            PG8_BAR; PG8_WAIT_L(0); PG8_MMA(0, 1, At, B1); PG8_BAR;
            PG8_LDA(At, 1, 1); PG8_STAGE(PG8_SA(1, 0), a3, voffA);
            PG8_BAR; PG8_WAIT_L(0); PG8_MMA(1, 0, At, B0); PG8_BAR; PG8_SCHED;
            PG8_STAGE(PG8_SB(1, 1), b3 + hstep, voffB);
            PG8_WAIT_V(6); PG8_BAR; PG8_MMA(1, 1, At, B1); PG8_BAR;
            }
        }
        if constexpr (ALIGN_EPI) { if (wr == 0) PG8_BAR; }
        if constexpr (!Epi::AFTER_DRAIN) { E(acc, cur, wr, wc, fr, fq); S.done(cur); }
        if (!has_next) break;
#pragma unroll
        for (int a = 0; a < 2; ++a)
#pragma unroll
            for (int b = 0; b < 2; ++b)
#pragma unroll
                for (int m = 0; m < 4; ++m)
#pragma unroll
                    for (int n = 0; n < 2; ++n) acc[a][b][m][n] = (f32x4){0.f, 0.f, 0.f, 0.f};
        cur = nxt; cA = nA; cB = nB; ++ui;
        if constexpr (ALIGN_EPI) { if (wr == 1) PG8_BAR; }
    }
    PG8_WAIT_V(0);
    if constexpr (!ALIGN_EPI) { if (wr == 0) PG8_BAR; }
    PG8_BAR;
    if constexpr (Epi::AFTER_DRAIN) { E.fused(acc, cur, wr, wc, fr, fq, lds, wid, lane); S.done(cur); }
#undef PG8_SA
#undef PG8_SB
#undef PG8_STAGE
#undef PG8_LDA
#undef PG8_LDB
#undef PG8_MMA
#undef PG8_WAIT_V
#undef PG8_WAIT_L
#undef PG8_BAR
#undef PG8_SCHED
}
}

using pg8::bf16_t; using pg8::bf16x8; using pg8::f32x4; using pg8::cvt_pk_bf16; using pg8::silu_f;
typedef short bf16x4 __attribute__((ext_vector_type(4)));

constexpr int NTOK = 32768, DM = 2048, SEQ = 8192, LDP = 5632, DFF = 5632, INW = 5648;
constexpr int PXBC = 1024, PAQ = 2560, PAK = 3072, PAV = 3584, PRQ = 4096, PRK = 4352, PRV = 4608, PRG = 5120;
constexpr int LDS_BYTES = 131072 + 16;

constexpr size_t SZ_WIN = (size_t)5632 * 2048 * 2, SZ_WOUT = (size_t)2048 * 2048 * 2, SZ_WGU = (size_t)11264 * 2048 * 2, SZ_WDN = (size_t)2048 * 5632 * 2;
constexpr size_t OFF_WIN = 0, OFF_WOUT = OFF_WIN + 2 * SZ_WIN, OFF_WGU = OFF_WOUT + 2 * SZ_WOUT, OFF_WDN = OFF_WGU + 2 * SZ_WGU;
constexpr size_t OFF_HN = OFF_WDN + 2 * SZ_WDN;
constexpr size_t OFF_Y = OFF_HN + (size_t)NTOK * DM * 2;
constexpr size_t OFF_PROJ = OFF_Y + (size_t)NTOK * DM * 2;
constexpr size_t OFF_SST = OFF_PROJ + (size_t)NTOK * LDP * 2;
constexpr size_t OFF_RST = OFF_SST + (size_t)4096 * 8192 * 2;
constexpr size_t OFF_LSE = OFF_RST + (size_t)1024 * 8192 * 4;
constexpr size_t OFF_DT = OFF_LSE + (size_t)3 * NTOK * 8 * 4;
constexpr size_t OFF_CDEC = OFF_DT + (size_t)NTOK * 16 * 4;
constexpr size_t OFF_ROPE = OFF_CDEC + (size_t)4096 * 4;
constexpr size_t OFF_XC = OFF_ROPE + (size_t)8192 * 32 * 4 * 2;
constexpr size_t OFF_BAR = OFF_XC + (size_t)NTOK * 1536 * 2;
constexpr size_t OFF_RSTD = OFF_BAR + (size_t)XCD_BAR_WORDS * 4;
constexpr size_t WS_END = OFF_RSTD + (size_t)NTOK * 4;

#ifndef REP_PREP
#define REP_PREP 1
#endif
#ifndef REP_NORM
#define REP_NORM 1
#endif
#ifndef REP_INPROJ
#define REP_INPROJ 1
#endif
#ifndef REP_M1
#define REP_M1 1
#endif
#ifndef REP_ATT
#define REP_ATT 1
#endif
#ifndef REP_ST
#define REP_ST 1
#endif
#ifndef REP_GU
#define REP_GU 1
#endif
#ifndef REP_NORM2
#define REP_NORM2 1
#endif
#ifndef REP_SYNC
#define REP_SYNC 0
#endif
#ifndef REP_M3
#define REP_M3 1
#endif
struct Params {
    const float *x, *ln_mix, *w_in, *conv_w, *conv_b, *dt_bias, *a_log, *d_skip, *ssd_norm, *q_norm, *k_norm, *ret_norm, *w_out, *ln_ffn, *w_gate, *w_up, *w_down;
    float* out;
    unsigned char* ws;
};

__device__ __forceinline__ bf16x8 as_bf8(uint4 v) { return __builtin_bit_cast(bf16x8, v); }
__device__ __forceinline__ bf16x8 cat4(bf16x4 a, bf16x4 b) { return __builtin_shufflevector(a, b, 0, 1, 2, 3, 4, 5, 6, 7); }
__device__ __forceinline__ uint4 pack8u(const float* v) { uint4 w; w.x = cvt_pk_bf16(v[0], v[1]); w.y = cvt_pk_bf16(v[2], v[3]); w.z = cvt_pk_bf16(v[4], v[5]); w.w = cvt_pk_bf16(v[6], v[7]); return w; }
__device__ __forceinline__ uint2 pack4u(float a, float b, float c, float d) { uint2 w; w.x = cvt_pk_bf16(a, b); w.y = cvt_pk_bf16(c, d); return w; }
__device__ __forceinline__ void unpack8(uint4 r, float* v) {
    v[0] = __uint_as_float(r.x << 16); v[1] = __uint_as_float(r.x & 0xffff0000u); v[2] = __uint_as_float(r.y << 16); v[3] = __uint_as_float(r.y & 0xffff0000u);
    v[4] = __uint_as_float(r.z << 16); v[5] = __uint_as_float(r.z & 0xffff0000u); v[6] = __uint_as_float(r.w << 16); v[7] = __uint_as_float(r.w & 0xffff0000u); }
__device__ __forceinline__ void unpack4(uint2 r, float* v) {
    v[0] = __uint_as_float(r.x << 16); v[1] = __uint_as_float(r.x & 0xffff0000u); v[2] = __uint_as_float(r.y << 16); v[3] = __uint_as_float(r.y & 0xffff0000u); }
__device__ __forceinline__ bf16_t f2bf(float f) { return (bf16_t)(cvt_pk_bf16(f, 0.f) & 0xffffu); }
__device__ __forceinline__ f32x4 mfma16(bf16x8 a, bf16x8 b, f32x4 c) { return __builtin_amdgcn_mfma_f32_16x16x32_bf16(a, b, c, 0, 0, 0); }
#define F4ZERO ((f32x4){0.f, 0.f, 0.f, 0.f})

struct WtTile { const float* src; const float* gk; bf16_t* dst; int ld, ldd; };
__device__ __forceinline__ WtTile wt_decode(const Params& p, int id) {
    WtTile T; const int layer = id / 12288; int r = id - layer * 12288;
    if (r < 2816) { const int kt = r / 88, nt = r - kt * 88, n0 = nt * 64;
        T.src = p.w_in + (size_t)layer * DM * INW + (size_t)(kt * 64) * INW + (n0 < 2560 ? n0 : n0 + 16); T.ld = INW; T.dst = (bf16_t*)(p.ws + OFF_WIN + layer * SZ_WIN) + (size_t)n0 * DM + kt * 64; T.ldd = DM; T.gk = p.ln_mix + layer * DM + kt * 64; }
    else if ((r -= 2816) < 1024) { const int kt = r >> 5, nt = r & 31;
        T.src = p.w_out + (size_t)layer * DM * DM + (size_t)(kt * 64) * DM + nt * 64; T.ld = DM; T.dst = (bf16_t*)(p.ws + OFF_WOUT + layer * SZ_WOUT) + (size_t)(nt * 64) * DM + kt * 64; T.ldd = DM; T.gk = nullptr; }
    else if ((r -= 1024) < 5632) { const int kt = r / 176, nt = r - kt * 176, n0 = nt * 64, pn = n0 >> 8, bj = (n0 >> 7) & 1, j0 = n0 & 127;
        T.src = (bj ? p.w_up : p.w_gate) + (size_t)layer * DM * DFF + (size_t)(kt * 64) * DFF + pn * 128 + j0; T.ld = DFF; T.dst = (bf16_t*)(p.ws + OFF_WGU + layer * SZ_WGU) + (size_t)n0 * DM + kt * 64; T.ldd = DM; T.gk = p.ln_ffn + layer * DM + kt * 64; }
    else { r -= 5632; const int kt = r >> 5, nt = r & 31;
        T.src = p.w_down + (size_t)layer * DFF * DM + (size_t)(kt * 64) * DM + nt * 64; T.ld = DM; T.dst = (bf16_t*)(p.ws + OFF_WDN + layer * SZ_WDN) + (size_t)(nt * 64) * DFF + kt * 64; T.ldd = DFF; T.gk = nullptr; }
    return T;
}
__device__ __forceinline__ void phase_prep(const Params& p, unsigned char* shm) {
    float* t = (float*)shm;
    int tid0_ = threadIdx.x; asm volatile("" : "+v"(tid0_)); const int tid = tid0_, nn = tid & 63, kk0 = tid >> 6;
    const int NT = 2 * 12288;
    int id = blockIdx.x;
    float r0, r1, r2, r3, r4, r5, r6, r7; r0 = r1 = r2 = r3 = r4 = r5 = r6 = r7 = 0.f;
    WtTile T; T.src = nullptr; T.gk = nullptr; T.dst = nullptr; T.ld = 0; T.ldd = 0;
#define WT_LOAD(TT) do { const float* s_ = (TT).src + (size_t)kk0 * (TT).ld + nn; const size_t st_ = (size_t)8 * (TT).ld; \
        r0 = s_[0]; r1 = s_[st_]; r2 = s_[2 * st_]; r3 = s_[3 * st_]; r4 = s_[4 * st_]; r5 = s_[5 * st_]; r6 = s_[6 * st_]; r7 = s_[7 * st_]; \
        if ((TT).gk) { const float* g_ = (TT).gk + kk0; r0 *= g_[0]; r1 *= g_[8]; r2 *= g_[16]; r3 *= g_[24]; r4 *= g_[32]; r5 *= g_[40]; r6 *= g_[48]; r7 *= g_[56]; } } while (0)
    if (id < NT) { T = wt_decode(p, id); WT_LOAD(T); }
#pragma unroll 1
    for (; id < NT; id += gridDim.x) {
        { float* tp = t + kk0 * 65 + nn; tp[0] = r0; tp[8 * 65] = r1; tp[16 * 65] = r2; tp[24 * 65] = r3; tp[32 * 65] = r4; tp[40 * 65] = r5; tp[48 * 65] = r6; tp[56 * 65] = r7; }
        WtTile Tn = T; const bool more = id + (int)gridDim.x < NT;
        if (more) { Tn = wt_decode(p, id + (int)gridDim.x); WT_LOAD(Tn); }
        __syncthreads();
        { const int kk = (tid & 31) * 2, nn0 = tid >> 5;
#pragma unroll
          for (int i = 0; i < 4; ++i) { const int n2 = nn0 + 16 * i; *(unsigned*)(T.dst + (size_t)n2 * T.ldd + kk) = cvt_pk_bf16(t[kk * 65 + n2], t[(kk + 1) * 65 + n2]); } }
        __syncthreads();
        T = Tn;
    }
#undef WT_LOAD
    float* cosT = (float*)(p.ws + OFF_ROPE); float* sinT = cosT + 8192 * 32;
    for (int e = blockIdx.x * 512 + threadIdx.x; e < 8192 * 32; e += gridDim.x * 512) {
        const int pos = e >> 5, i = e & 31;
        const float inv = (float)exp(-(double)i * (9.210340371976184 / 32.0));
        const float ang = (float)pos * inv;
        const double rev = (double)ang * 0.15915494309189535; const float fr = (float)(rev - rint(rev));
        cosT[e] = __builtin_amdgcn_cosf(fr); sinT[e] = __builtin_amdgcn_sinf(fr);
    }
}

template <bool WITH_DT, bool XF32>
__device__ __forceinline__ void phase_resid(const float* __restrict__ xf, bf16_t* xb, const bf16_t* delta, bf16_t* hn, const float* __restrict__ g, const float* w_in_l, const float* dt_bias, float* dtbuf, unsigned char* shm) {
    int tid0_ = threadIdx.x; asm volatile("" : "+v"(tid0_)); const int tid = tid0_, lane = tid & 63, wid = tid >> 6;
    bf16_t* wlb = (bf16_t*)shm;
    constexpr int RG = WITH_DT ? 16 : 1;
    if (WITH_DT) {
        for (int k = tid; k < 2048; k += 512) {
            const float4* s = (const float4*)(w_in_l + (size_t)k * INW + 2560); const float gk = g[k];
#pragma unroll
            for (int q = 0; q < 4; ++q) { const float4 v = s[q]; wlb[(4 * q + 0) * 2056 + k] = f2bf(v.x * gk); wlb[(4 * q + 1) * 2056 + k] = f2bf(v.y * gk); wlb[(4 * q + 2) * 2056 + k] = f2bf(v.z * gk); wlb[(4 * q + 3) * 2056 + k] = f2bf(v.w * gk); } }
        __syncthreads();
    }
#pragma unroll 1
    for (int rowg = (blockIdx.x * 8 + wid) * RG; rowg < NTOK; rowg += gridDim.x * 8 * RG) {
#pragma unroll 1
        for (int row = rowg; row < rowg + RG; ++row) {
            float4 v[8];
            if (XF32) {
#pragma unroll
                for (int i = 0; i < 8; ++i) v[i] = *(const float4*)(xf + (size_t)row * DM + i * 256 + lane * 4);
            } else {
                uint2 xr[8];
#pragma unroll
                for (int i = 0; i < 8; ++i) xr[i] = *(const uint2*)(xb + (size_t)row * DM + i * 256 + lane * 4);
#pragma unroll
                for (int i = 0; i < 8; ++i) { float x4[4]; unpack4(xr[i], x4); v[i].x = x4[0]; v[i].y = x4[1]; v[i].z = x4[2]; v[i].w = x4[3]; }
            }
            if (delta) {
                uint2 dl[8];
#pragma unroll
                for (int i = 0; i < 8; ++i) dl[i] = *(const uint2*)(delta + (size_t)row * DM + i * 256 + lane * 4);
#pragma unroll
                for (int i = 0; i < 8; ++i) { float d4[4]; unpack4(dl[i], d4); v[i].x += d4[0]; v[i].y += d4[1]; v[i].z += d4[2]; v[i].w += d4[3]; }
            }
            float ss = 0.f;
#pragma unroll
            for (int i = 0; i < 8; ++i) ss += v[i].x * v[i].x + v[i].y * v[i].y + v[i].z * v[i].z + v[i].w * v[i].w;
#pragma unroll
            for (int o = 32; o >= 1; o >>= 1) ss += __shfl_xor(ss, o);
            const float rstd = rsqrtf(ss * (1.0f / DM) + 1e-6f);
#pragma unroll
            for (int i = 0; i < 8; ++i) {
                if (XF32 || delta) *(uint2*)(xb + (size_t)row * DM + i * 256 + lane * 4) = pack4u(v[i].x, v[i].y, v[i].z, v[i].w);
                *(uint2*)(hn + (size_t)row * DM + i * 256 + lane * 4) = pack4u(v[i].x * rstd, v[i].y * rstd, v[i].z * rstd, v[i].w * rstd); }
        }
        if (WITH_DT) {
            const int lr = lane & 15, g4 = lane >> 4;
            __builtin_amdgcn_fence(__ATOMIC_RELEASE, "workgroup"); asm volatile("s_waitcnt vmcnt(0)" ::: "memory"); __builtin_amdgcn_fence(__ATOMIC_ACQUIRE, "workgroup");
            f32x4 acc = F4ZERO;
            const bf16_t* ap = hn + (size_t)(rowg + lr) * DM + g4 * 8; const bf16_t* bp = wlb + lr * 2056 + g4 * 8;
#pragma unroll 8
            for (int ks = 0; ks < 64; ++ks) acc = mfma16(*(const bf16x8*)(ap + ks * 32), *(const bf16x8*)(bp + ks * 32), acc);
            const float bias = dt_bias[lr];
#pragma unroll
            for (int q = 0; q < 4; ++q) { const float xv = acc[q] + bias; dtbuf[(size_t)(rowg + 4 * g4 + q) * 16 + lr] = fmaxf(xv, 0.f) + log1pf(__expf(-fabsf(xv))); }
        }
    }
    __syncthreads();
}

#ifndef GEMM_SP2
#define GEMM_SP2 true
#endif
#ifndef GEMM_ALIGN
#define GEMM_ALIGN true
#endif
template <class Epi>
__device__ __forceinline__ void run_gemm(unsigned char* shm, const bf16_t* A, const bf16_t* Bt, int M, int N, int K, const Epi& E, int vb, unsigned long long* pst = nullptr) {
    pg8::Gemm g; g.A = A; g.Bt = Bt; g.M = M; g.N = N; g.K = K;
    pg8::StaticOrder S; S.init(M, N, (int)gridDim.x, vb);
    (void)pst; pg8::gemm_phase<Epi, pg8::StaticOrder, GEMM_ALIGN, GEMM_SP2>((PG8_LAS unsigned char*)shm, g, S, E);
    __syncthreads();
}

__device__ __forceinline__ void rope8(float* v, const float* cosT, const float* sinT, int t, int sub, float sc) {
    const float* cp = cosT + t * 32 + (sub & 3) * 8; const float* sp = sinT + t * 32 + (sub & 3) * 8;
    const float4 c0 = *(const float4*)cp, c1 = *(const float4*)(cp + 4), s0 = *(const float4*)sp, s1 = *(const float4*)(sp + 4);
    const float cc[8] = {c0.x, c0.y, c0.z, c0.w, c1.x, c1.y, c1.z, c1.w}; const float sn[8] = {s0.x, s0.y, s0.z, s0.w, s1.x, s1.y, s1.z, s1.w};
#pragma unroll
    for (int i = 0; i < 8; ++i) { const float pv = __shfl_xor(v[i], 4); v[i] = ((sub < 4) ? (v[i] * cc[i] - pv * sn[i]) : (pv * sn[i] + v[i] * cc[i])) * sc; }
}
__device__ __forceinline__ void phase_pre(const Params& p, int layer) {
    int tid0_ = threadIdx.x; asm volatile("" : "+v"(tid0_)); const int tid = tid0_;
    bf16_t* proj = (bf16_t*)(p.ws + OFF_PROJ); bf16_t* xc = (bf16_t*)(p.ws + OFF_XC);
    const float* cosT = (const float*)(p.ws + OFF_ROPE); const float* sinT = cosT + 8192 * 32;
    const float* cw = p.conv_w + layer * 4 * 1536; const float* cb = p.conv_b + layer * 1536;
    for (int it = blockIdx.x; it < 256; it += gridDim.x) {
        if (tid < 384) {
            const int cg = tid % 192, half = tid / 192, ch = cg * 8, c = it & 63, l0 = half * 64;
            const size_t tokbase = (size_t)it * 128;
            float wk[4][8], bias[8];
            { const float4 b0 = *(const float4*)(cb + ch), b1 = *(const float4*)(cb + ch + 4); bias[0] = b0.x; bias[1] = b0.y; bias[2] = b0.z; bias[3] = b0.w; bias[4] = b1.x; bias[5] = b1.y; bias[6] = b1.z; bias[7] = b1.w; }
#pragma unroll
            for (int k = 0; k < 4; ++k) { const float4 w0 = *(const float4*)(cw + k * 1536 + ch), w1 = *(const float4*)(cw + k * 1536 + ch + 4);
                wk[k][0] = w0.x; wk[k][1] = w0.y; wk[k][2] = w0.z; wk[k][3] = w0.w; wk[k][4] = w1.x; wk[k][5] = w1.y; wk[k][6] = w1.z; wk[k][7] = w1.w; }
            float h0[8], h1[8], h2[8];
            { uint4 r0 = make_uint4(0u, 0u, 0u, 0u), r1 = r0, r2 = r0;
              if (c * 128 + l0 - 3 >= 0) { r0 = *(const uint4*)(proj + (tokbase + l0 - 3) * LDP + PXBC + ch); r1 = *(const uint4*)(proj + (tokbase + l0 - 2) * LDP + PXBC + ch); r2 = *(const uint4*)(proj + (tokbase + l0 - 1) * LDP + PXBC + ch); }
              unpack8(r0, h0); unpack8(r1, h1); unpack8(r2, h2); }
#pragma unroll 1
            for (int lb = 0; lb < 64; lb += 8) {
                uint4 raw[8];
#pragma unroll
                for (int i = 0; i < 8; ++i) raw[i] = *(const uint4*)(proj + (tokbase + l0 + lb + i) * LDP + PXBC + ch);
#pragma unroll
                for (int i = 0; i < 8; ++i) { float xv[8], o[8]; unpack8(raw[i], xv);
#pragma unroll
                    for (int e = 0; e < 8; ++e) { o[e] = silu_f(bias[e] + wk[0][e] * h0[e] + wk[1][e] * h1[e] + wk[2][e] * h2[e] + wk[3][e] * xv[e]); h0[e] = h1[e]; h1[e] = h2[e]; h2[e] = xv[e]; }
                    *(uint4*)(xc + (tokbase + l0 + lb + i) * 1536 + ch) = pack8u(o); }
            }
        }
    }
    const int sub = tid & 7, grp = (blockIdx.x * 512 + tid) >> 3, ngrp = gridDim.x * 64;
    const float* qg = p.q_norm + layer * 64; const float* kg = p.k_norm + layer * 64;
#pragma unroll 4
    for (int rt = grp; rt < NTOK * 16; rt += ngrp) {
        const int tok = rt >> 4, hk = rt & 15; bf16_t* ptr = proj + (size_t)tok * LDP + PAQ + hk * 64 + sub * 8;
        float v[8]; unpack8(*(const uint4*)ptr, v);
        float ss = 0.f;
#pragma unroll
        for (int i = 0; i < 8; ++i) ss += v[i] * v[i];
        ss += __shfl_xor(ss, 1); ss += __shfl_xor(ss, 2); ss += __shfl_xor(ss, 4);
        const float rstd = rsqrtf(ss * (1.0f / 64.0f) + 1e-6f);
        const float* gp = (hk < 8 ? qg : kg) + sub * 8; const float4 g0 = *(const float4*)gp, g1 = *(const float4*)(gp + 4);
        v[0] *= rstd * g0.x; v[1] *= rstd * g0.y; v[2] *= rstd * g0.z; v[3] *= rstd * g0.w; v[4] *= rstd * g1.x; v[5] *= rstd * g1.y; v[6] *= rstd * g1.z; v[7] *= rstd * g1.w;
        rope8(v, cosT, sinT, tok & (SEQ - 1), sub, hk < 8 ? 0.125f : 1.0f);
        *(uint4*)ptr = pack8u(v);
    }
}

template <int W>
__device__ __forceinline__ void stage_tr(const bf16_t* __restrict__ src, int ld, size_t tokbase, bf16_t* dst, int stride, const float* rs, int tid) {
    const int l = tid & 127, cgi = tid >> 7;
    uint4 raw[W / 32];
#pragma unroll
    for (int it = 0; it < W / 32; ++it) raw[it] = *(const uint4*)(src + (tokbase + l) * ld + cgi * 8 + 32 * it);
    if (rs) { const float sc = rs[l];
#pragma unroll
        for (int it = 0; it < W / 32; ++it) { float v[8]; unpack8(raw[it], v);
#pragma unroll
            for (int i = 0; i < 8; ++i) v[i] *= sc;
            raw[it] = pack8u(v); } }
#pragma unroll
    for (int it = 0; it < W / 32; ++it) { bf16_t* vp = dst + (cgi * 8 + 32 * it) * stride + l; const uint4 r = raw[it];
        vp[0] = (bf16_t)(r.x & 0xffffu); vp[stride] = (bf16_t)(r.x >> 16); vp[2 * stride] = (bf16_t)(r.y & 0xffffu); vp[3 * stride] = (bf16_t)(r.y >> 16);
        vp[4 * stride] = (bf16_t)(r.z & 0xffffu); vp[5 * stride] = (bf16_t)(r.z >> 16); vp[6 * stride] = (bf16_t)(r.w & 0xffffu); vp[7 * stride] = (bf16_t)(r.w >> 16); }
}
template <int W>
__device__ __forceinline__ void stage_nat(const bf16_t* __restrict__ src, int ld, size_t tokbase, bf16_t* dst, int stride, int tid) {
    constexpr int CG = W / 8, RP = 512 / CG, NP = 128 / RP;
    const int cg = tid % CG, r0 = tid / CG;
    uint4 raw[NP];
#pragma unroll
    for (int it = 0; it < NP; ++it) raw[it] = *(const uint4*)(src + (tokbase + r0 + it * RP) * ld + cg * 8);
#pragma unroll
    for (int it = 0; it < NP; ++it) *(uint4*)(dst + (r0 + it * RP) * stride + cg * 8) = raw[it];
}

__device__ __forceinline__ float head_acum(const float* __restrict__ dtbuf, size_t tokbase, int hh, float a_neg, int lane, float& d0, float& d1, float& ac0, float& ac1) {
    const int l0 = 2 * lane;
    d0 = dtbuf[(tokbase + l0) * 16 + hh]; d1 = dtbuf[(tokbase + l0 + 1) * 16 + hh];
    const float v0 = d0 * a_neg, v1 = d1 * a_neg; float s = v0 + v1;
#pragma unroll
    for (int o = 1; o < 64; o <<= 1) { const float t = __shfl_up(s, o); if (lane >= o) s += t; }
    ac0 = s - v1; ac1 = s;
    return __shfl(s, 63);
}

struct AttId { int b, h, br, d, r, n; };
__device__ __forceinline__ AttId att_decode(int idx) {
    AttId a; a.br = idx >> 11; const int rem = idx & 2047, bh = rem >> 6, jj = rem & 63, dsh = 2 * a.br;
    a.d = 1 << dsh; a.r = jj >> (6 - dsh); a.n = jj & ((64 >> dsh) - 1); a.b = bh >> 3; a.h = bh & 7; return a;
}
__device__ __forceinline__ void att_run(const Params& p, int u0, int cnt, unsigned char* shm) {
    int tid0_ = threadIdx.x; asm volatile("" : "+v"(tid0_)); const int tid = tid0_, lane = tid & 63, w = __builtin_amdgcn_readfirstlane(tid >> 6), lr = lane & 15, g4 = lane >> 4;
    if (cnt <= 0) return;
    bf16_t* Qs = (bf16_t*)shm; bf16_t* Ks = Qs + 128 * 72; bf16_t* Vt = Ks + 256 * 72;
    const bf16_t* proj = (const bf16_t*)(p.ws + OFF_PROJ);
    const int sub = tid & 7, rloc = tid >> 3;
    AttId a = att_decode(u0);
    uint4 rq0, rq1, rk0, rk1, rv0, rv1;
    { const bf16_t* base = proj + ((size_t)a.b * SEQ + a.r) * LDP + a.h * 64 + sub * 8; const size_t rs = (size_t)a.d * LDP;
      { const bf16_t* rp = base + (size_t)(a.n * 128 + rloc) * rs; rq0 = *(const uint4*)(rp + PAQ); rk0 = *(const uint4*)(rp + PAK); rv0 = *(const uint4*)(rp + PAV); }
      { const bf16_t* rp = base + (size_t)(a.n * 128 + 64 + rloc) * rs; rq1 = *(const uint4*)(rp + PAQ); rk1 = *(const uint4*)(rp + PAK); rv1 = *(const uint4*)(rp + PAV); }
      if (a.n > 0) {
          const int ps_slot = (a.n - 1) & 1;
#pragma unroll
          for (int ps = 0; ps < 2; ++ps) { const int li = ps * 64 + rloc; const bf16_t* rp = base + (size_t)((a.n - 1) * 128 + li) * rs;
              const uint4 k = *(const uint4*)(rp + PAK), v = *(const uint4*)(rp + PAV);
              *(uint4*)(Ks + (ps_slot * 128 + li) * 72 + sub * 8) = k;
              bf16_t* vp = Vt + (sub * 8) * 264 + ps_slot * 128 + li;
              vp[0] = (bf16_t)(v.x & 0xffffu); vp[264] = (bf16_t)(v.x >> 16); vp[528] = (bf16_t)(v.y & 0xffffu); vp[792] = (bf16_t)(v.y >> 16);
              vp[1056] = (bf16_t)(v.z & 0xffffu); vp[1320] = (bf16_t)(v.z >> 16); vp[1584] = (bf16_t)(v.w & 0xffffu); vp[1848] = (bf16_t)(v.w >> 16); } } }
#pragma unroll 1
    for (int k = 0; k < cnt; ++k) {
        const int slot = a.n & 1;
        if (a.n == 0) { const uint4 z = make_uint4(0u, 0u, 0u, 0u); bf16_t* zp = Vt + (tid >> 3) * 264 + 128 + (tid & 7) * 16; *(uint4*)zp = z; *(uint4*)(zp + 8) = z; }
#pragma unroll
        for (int ps = 0; ps < 2; ++ps) { const int li = ps * 64 + rloc;
            *(uint4*)(Qs + li * 72 + sub * 8) = ps ? rq1 : rq0; *(uint4*)(Ks + (slot * 128 + li) * 72 + sub * 8) = ps ? rk1 : rk0;
            bf16_t* vp = Vt + (sub * 8) * 264 + slot * 128 + li; const uint4 v = ps ? rv1 : rv0;
            vp[0] = (bf16_t)(v.x & 0xffffu); vp[264] = (bf16_t)(v.x >> 16); vp[528] = (bf16_t)(v.y & 0xffffu); vp[792] = (bf16_t)(v.y >> 16);
            vp[1056] = (bf16_t)(v.z & 0xffffu); vp[1320] = (bf16_t)(v.z >> 16); vp[1584] = (bf16_t)(v.w & 0xffffu); vp[1848] = (bf16_t)(v.w >> 16); }
        const bool has_next = (k + 1 < cnt);
        AttId nx = a;
        if (has_next) { nx = att_decode(u0 + k + 1);
            const bf16_t* base = proj + ((size_t)nx.b * SEQ + nx.r) * LDP + nx.h * 64 + sub * 8; const size_t rs = (size_t)nx.d * LDP;
            { const bf16_t* rp = base + (size_t)(nx.n * 128 + rloc) * rs; rq0 = *(const uint4*)(rp + PAQ); rk0 = *(const uint4*)(rp + PAK); rv0 = *(const uint4*)(rp + PAV); }
            { const bf16_t* rp = base + (size_t)(nx.n * 128 + 64 + rloc) * rs; rq1 = *(const uint4*)(rp + PAQ); rk1 = *(const uint4*)(rp + PAK); rv1 = *(const uint4*)(rp + PAV); } }
        __syncthreads();
        const int iq = 16 * w + lr, n = a.n;
        bf16x8 qf[2];
#pragma unroll
        for (int ks = 0; ks < 2; ++ks) qf[ks] = *(const bf16x8*)(Qs + iq * 72 + ks * 32 + g4 * 8);
        f32x4 s[9]; float mx = -INFINITY;
#pragma unroll
        for (int i = 0; i < 9; ++i) { f32x4 acc = F4ZERO; const int T = w + i; const int krow = (((T < 8) ? (slot ^ 1) : slot) * 128) + (T & 7) * 16 + lr;
#pragma unroll
            for (int ks = 0; ks < 2; ++ks) acc = mfma16(*(const bf16x8*)(Ks + krow * 72 + ks * 32 + g4 * 8), qf[ks], acc);
#pragma unroll
            for (int q = 0; q < 4; ++q) {
                const int dq = 4 * g4 + q - lr; bool ok = (i == 0) ? (dq >= 0) : ((i == 8) ? (dq <= 0) : true);
                if (n == 0) ok = ok && (T >= 8);
                acc[q] = ok ? acc[q] : -INFINITY; mx = fmaxf(mx, acc[q]); }
            s[i] = acc; }
        mx = fmaxf(mx, __shfl_xor(mx, 16)); mx = fmaxf(mx, __shfl_xor(mx, 32));
        float den = 0.f; const float mx2 = mx * 1.4426950408889634f;
#pragma unroll
        for (int i = 0; i < 9; ++i)
#pragma unroll
            for (int q = 0; q < 4; ++q) { const float e = __builtin_amdgcn_exp2f(__builtin_fmaf(s[i][q], 1.4426950408889634f, -mx2)); s[i][q] = e; den += e; }
        den += __shfl_xor(den, 16); den += __shfl_xor(den, 32);
        f32x4 o[4] = {F4ZERO, F4ZERO, F4ZERO, F4ZERO};
#pragma unroll
        for (int pi = 0; pi < 5; ++pi) {
            const f32x4 p0 = s[2 * pi], p1 = (2 * pi + 1 < 9) ? s[(2 * pi + 1 < 9) ? 2 * pi + 1 : 0] : F4ZERO;
            uint4 pw; pw.x = cvt_pk_bf16(p0[0], p0[1]); pw.y = cvt_pk_bf16(p0[2], p0[3]); pw.z = cvt_pk_bf16(p1[0], p1[1]); pw.w = cvt_pk_bf16(p1[2], p1[3]);
            const bf16x8 pf = as_bf8(pw);
            const int T0 = w + 2 * pi, T1 = (T0 + 1 < 16) ? T0 + 1 : 15;
            const int c0 = (((T0 < 8) ? (slot ^ 1) : slot) * 128) + (T0 & 7) * 16 + 4 * g4, c1 = (((T1 < 8) ? (slot ^ 1) : slot) * 128) + (T1 & 7) * 16 + 4 * g4;
#pragma unroll
            for (int dt = 0; dt < 4; ++dt) { const bf16_t* vr = Vt + (dt * 16 + lr) * 264;
                o[dt] = mfma16(cat4(*(const bf16x4*)(vr + c0), *(const bf16x4*)(vr + c1)), pf, o[dt]); }
        }
        const float inv = 1.0f / den;
        const size_t tok = (size_t)a.b * SEQ + (size_t)(n * 128 + iq) * a.d + a.r;
        bf16_t* op = (bf16_t*)p.out + ((size_t)a.br * NTOK + tok) * 512 + a.h * 64;
#pragma unroll
        for (int dt = 0; dt < 4; ++dt) *(uint2*)(op + dt * 16 + 4 * g4) = pack4u(o[dt][0] * inv, o[dt][1] * inv, o[dt][2] * inv, o[dt][3] * inv);
        if (g4 == 0) ((float*)(p.ws + OFF_LSE))[((size_t)a.br * NTOK + tok) * 8 + a.h] = mx + __logf(den);
        __syncthreads();
        a = nx;
    }
}

__device__ __forceinline__ void ssd_state_item(const Params& p, int layer, int idx, unsigned char* shm) {
    int tid0_ = threadIdx.x; asm volatile("" : "+v"(tid0_)); const int tid = tid0_, lane = tid & 63, w = __builtin_amdgcn_readfirstlane(tid >> 6), lr = lane & 15, g4 = lane >> 4;
    const int g = idx & 1, bc = idx >> 1;
    const size_t tokbase = (size_t)bc * 128;
    bf16_t* Bt = (bf16_t*)shm; bf16_t* Xt = Bt + 128 * 136; float* wsc = (float*)(shm + 52224);
    const bf16_t* xc = (const bf16_t*)(p.ws + OFF_XC);
    const float* dtbuf = (const float*)(p.ws + OFF_DT);
    { const int hh = 8 * g + w; float d0, d1, a0, a1;
      const float tot = head_acum(dtbuf, tokbase, hh, -__expf(p.a_log[layer * 16 + hh]), lane, d0, d1, a0, a1);
      wsc[w * 128 + 2 * lane] = __expf(tot - a0) * d0; wsc[w * 128 + 2 * lane + 1] = __expf(tot - a1) * d1;
      if (lane == 0) ((float*)(p.ws + OFF_CDEC))[bc * 16 + hh] = __expf(tot); }
    const int sl = tid & 127, scg = tid >> 7;
    uint4 xa, xb2;
    { const bf16_t* xs = xc + (tokbase + sl) * 1536 + (8 * g) * 64 + scg * 8; xa = *(const uint4*)xs; xb2 = *(const uint4*)(xs + 32); }
    stage_tr<128>(xc + 1024 + g * 128, 1536, tokbase, Bt, 136, nullptr, tid);
#pragma unroll 1
    for (int j = 0; j < 8; ++j) {
        const int hh = 8 * g + j;
        __syncthreads();
        { const float sc = wsc[j * 128 + sl];
#pragma unroll
          for (int it = 0; it < 2; ++it) { float v[8]; unpack8(it ? xb2 : xa, v);
#pragma unroll
              for (int i = 0; i < 8; ++i) Xt[(scg * 8 + 32 * it + i) * 136 + sl] = f2bf(v[i] * sc); } }
        if (j < 7) { const bf16_t* xs = xc + (tokbase + sl) * 1536 + (hh + 1) * 64 + scg * 8; xa = *(const uint4*)xs; xb2 = *(const uint4*)(xs + 32); }
        __syncthreads();
        f32x4 acc[4] = {F4ZERO, F4ZERO, F4ZERO, F4ZERO};
#pragma unroll
        for (int ks = 0; ks < 4; ++ks) { const bf16x8 af = *(const bf16x8*)(Bt + (w * 16 + lr) * 136 + ks * 32 + g4 * 8);
#pragma unroll
            for (int pt = 0; pt < 4; ++pt) acc[pt] = mfma16(af, *(const bf16x8*)(Xt + (pt * 16 + lr) * 136 + ks * 32 + g4 * 8), acc[pt]); }
        bf16_t* sp = (bf16_t*)(p.ws + OFF_SST) + ((size_t)bc * 16 + hh) * 8192;
#pragma unroll
        for (int pt = 0; pt < 4; ++pt) *(uint2*)(sp + (pt * 16 + lr) * 128 + w * 16 + 4 * g4) = pack4u(acc[pt][0], acc[pt][1], acc[pt][2], acc[pt][3]);
    }
    __syncthreads();
}

__device__ __forceinline__ void ret_state_item(const Params& p, int idx, unsigned char* shm) {
    int tid0_ = threadIdx.x; asm volatile("" : "+v"(tid0_)); const int tid = tid0_, lane = tid & 63, w = __builtin_amdgcn_readfirstlane(tid >> 6), lr = lane & 15, g4 = lane >> 4;
    const int h = idx & 3, bc = idx >> 2;
    const size_t tokbase = (size_t)bc * 128;
    bf16_t* Kt = (bf16_t*)shm; bf16_t* Vt = Kt + 64 * 136; float* wsc = (float*)(shm + 52224);
    const bf16_t* proj = (const bf16_t*)(p.ws + OFF_PROJ);
    const float lg = log1pf(-exp2f(-5.0f - (float)h));
    if (tid < 128) wsc[tid] = __expf((float)(127 - tid) * lg);
    stage_tr<128>(proj + PRV + h * 128, LDP, tokbase, Vt, 136, nullptr, tid);
    __syncthreads();
    { const int l = tid & 127, cgi = tid >> 7, t = (bc & 63) * 128 + l;
      const float* cosT = (const float*)(p.ws + OFF_ROPE); const float* sinT = cosT + 8192 * 32;
      const bf16_t* src = proj + (tokbase + l) * LDP + PRK + h * 64 + cgi * 8;
      float v1[8], v2[8]; unpack8(*(const uint4*)src, v1); unpack8(*(const uint4*)(src + 32), v2);
      const float* cp = cosT + t * 32 + cgi * 8; const float* sp = sinT + t * 32 + cgi * 8;
      const float4 c0 = *(const float4*)cp, c1 = *(const float4*)(cp + 4), s0 = *(const float4*)sp, s1 = *(const float4*)(sp + 4);
      const float cc[8] = {c0.x, c0.y, c0.z, c0.w, c1.x, c1.y, c1.z, c1.w}; const float sn[8] = {s0.x, s0.y, s0.z, s0.w, s1.x, s1.y, s1.z, s1.w};
      const float sc = 0.125f * wsc[l];
#pragma unroll
      for (int i = 0; i < 8; ++i) { Kt[(cgi * 8 + i) * 136 + l] = f2bf((v1[i] * cc[i] - v2[i] * sn[i]) * sc); Kt[(32 + cgi * 8 + i) * 136 + l] = f2bf((v1[i] * sn[i] + v2[i] * cc[i]) * sc); } }
    __syncthreads();
    f32x4 acc[4] = {F4ZERO, F4ZERO, F4ZERO, F4ZERO};
#pragma unroll
    for (int ks = 0; ks < 4; ++ks) { const bf16x8 bfr = *(const bf16x8*)(Vt + (w * 16 + lr) * 136 + ks * 32 + g4 * 8);
#pragma unroll
        for (int dt = 0; dt < 4; ++dt) acc[dt] = mfma16(*(const bf16x8*)(Kt + (dt * 16 + lr) * 136 + ks * 32 + g4 * 8), bfr, acc[dt]); }
    float* rp = (float*)(p.ws + OFF_RST) + ((size_t)bc * 4 + h) * 8192 + (w * 16 + lr) * 64;
#pragma unroll
    for (int dt = 0; dt < 4; ++dt) *(f32x4*)(rp + dt * 16 + 4 * g4) = acc[dt];
    __syncthreads();
}
__device__ __forceinline__ void phase_scan(const Params& p) {
    int tid0_ = threadIdx.x; asm volatile("" : "+v"(tid0_)); const int nth = gridDim.x * 512, gid = blockIdx.x * 512 + tid0_;
    const float* cdec = (const float*)(p.ws + OFF_CDEC);
    for (int it = gid; it < 131072; it += nth) {
        const int n4 = it & 31, pp = (it >> 5) & 63, hh = (it >> 11) & 15, b = it >> 15;
        const int rd = it & 63, re = (it >> 6) & 127, rh = (it >> 13) & 3;
        float st[4] = {0.f, 0.f, 0.f, 0.f}; float rs = 0.f;
        const float rdec = __expf(128.0f * log1pf(-exp2f(-5.0f - (float)rh)));
        bf16_t* base = (bf16_t*)(p.ws + OFF_SST) + ((size_t)(b * 64) * 16 + hh) * 8192 + pp * 128 + n4 * 4;
        float* rbase = (float*)(p.ws + OFF_RST) + ((size_t)(b * 64) * 4 + rh) * 8192 + re * 64 + rd;
#pragma unroll 8
        for (int c = 0; c < 64; ++c) {
            uint2* a = (uint2*)(base + (size_t)c * 16 * 8192); const uint2 raw = *a; const float dec = cdec[(b * 64 + c) * 16 + hh];
            float* ra = rbase + (size_t)c * 4 * 8192; const float rv = *ra;
            float v[4]; unpack4(raw, v);
            *a = pack4u(st[0], st[1], st[2], st[3]); *ra = rs;
            st[0] = st[0] * dec + v[0]; st[1] = st[1] * dec + v[1]; st[2] = st[2] * dec + v[2]; st[3] = st[3] * dec + v[3];
            rs = rs * rdec + rv;
        }
    }
    const bf16_t* ao = (const bf16_t*)p.out; const float* lse = (const float*)(p.ws + OFF_LSE); bf16_t* y = (bf16_t*)(p.ws + OFF_Y);
    for (int it = gid; it < NTOK * 64; it += nth) {
        const int sub = it & 7, h = (it >> 3) & 7, tok = it >> 6;
        const float l0 = lse[(size_t)tok * 8 + h], l1 = lse[((size_t)NTOK + tok) * 8 + h], l2 = lse[((size_t)2 * NTOK + tok) * 8 + h];
        const float m = fmaxf(l0, fmaxf(l1, l2)); float w0 = __expf(l0 - m), w1 = __expf(l1 - m), w2 = __expf(l2 - m); const float inv = 1.0f / (w0 + w1 + w2); w0 *= inv; w1 *= inv; w2 *= inv;
        float a0[8], a1[8], a2[8], o[8];
        unpack8(*(const uint4*)(ao + (size_t)tok * 512 + h * 64 + sub * 8), a0);
        unpack8(*(const uint4*)(ao + ((size_t)NTOK + tok) * 512 + h * 64 + sub * 8), a1);
        unpack8(*(const uint4*)(ao + ((size_t)2 * NTOK + tok) * 512 + h * 64 + sub * 8), a2);
#pragma unroll
        for (int i = 0; i < 8; ++i) o[i] = w0 * a0[i] + w1 * a1[i] + w2 * a2[i];
        *(uint4*)(y + (size_t)tok * DM + 1024 + h * 64 + sub * 8) = pack8u(o);
    }
}

__device__ __forceinline__ void ssd_out_item(const Params& p, int layer, int idx, unsigned char* shm) {
    int tid0_ = threadIdx.x; asm volatile("" : "+v"(tid0_)); const int tid = tid0_, lane = tid & 63, w = __builtin_amdgcn_readfirstlane(tid >> 6), lr = lane & 15, g4 = lane >> 4;
    const int g = idx & 1, bc = idx >> 1;
    const size_t tokbase = (size_t)bc * 128;
    bf16_t* Cs = (bf16_t*)shm; bf16_t* Bs = Cs + 128 * 136; bf16_t* Xt = Bs + 128 * 136; bf16_t* Pv = Xt + 64 * 136;
    float* dts = (float*)(shm + 104448); float* acs = dts + 8 * 128;
    const bf16_t* proj = (const bf16_t*)(p.ws + OFF_PROJ); const bf16_t* xc = (const bf16_t*)(p.ws + OFF_XC);
    const float* dtbuf = (const float*)(p.ws + OFF_DT);
    bf16_t* y = (bf16_t*)(p.ws + OFF_Y);
    const int sl = tid & 127, scg = tid >> 7;
    uint4 xr0, xr1, pr0, pr1;
    { const bf16_t* xs = xc + (tokbase + sl) * 1536 + (8 * g) * 64 + scg * 8; xr0 = *(const uint4*)xs; xr1 = *(const uint4*)(xs + 32);
      const bf16_t* ps = (const bf16_t*)(p.ws + OFF_SST) + ((size_t)bc * 16 + 8 * g) * 8192 + tid * 8; pr0 = *(const uint4*)ps; pr1 = *(const uint4*)(ps + 4096); }
    { const int hh = 8 * g + w; float d0, d1, a0, a1;
      (void)head_acum(dtbuf, tokbase, hh, -__expf(p.a_log[layer * 16 + hh]), lane, d0, d1, a0, a1);
      dts[w * 128 + 2 * lane] = d0; dts[w * 128 + 2 * lane + 1] = d1; acs[w * 128 + 2 * lane] = a0; acs[w * 128 + 2 * lane + 1] = a1; }
    stage_nat<128>(xc + 1280 + g * 128, 1536, tokbase, Cs, 136, tid);
    stage_nat<128>(xc + 1024 + g * 128, 1536, tokbase, Bs, 136, tid);
    __syncthreads();
    const int l = w * 16 + lr;
    bf16x8 cf[4];
#pragma unroll
    for (int ks = 0; ks < 4; ++ks) cf[ks] = *(const bf16x8*)(Cs + l * 136 + ks * 32 + g4 * 8);
    f32x4 cbt[8];
#pragma unroll
    for (int st = 0; st < 8; ++st) { cbt[st] = F4ZERO;
        if (st <= w) {
#pragma unroll
            for (int ks = 0; ks < 4; ++ks) cbt[st] = mfma16(*(const bf16x8*)(Bs + (st * 16 + lr) * 136 + ks * 32 + g4 * 8), cf[ks], cbt[st]); } }
    float ssq = 0.f;
    const size_t tok = tokbase + l;
#pragma unroll 1
    for (int j = 0; j < 8; ++j) {
        const int hh = 8 * g + j;
        __syncthreads();
#pragma unroll
        for (int it = 0; it < 2; ++it) { bf16_t* vp = Xt + (scg * 8 + 32 * it) * 136 + sl; const uint4 r = it ? xr1 : xr0;
            vp[0] = (bf16_t)(r.x & 0xffffu); vp[136] = (bf16_t)(r.x >> 16); vp[272] = (bf16_t)(r.y & 0xffffu); vp[408] = (bf16_t)(r.y >> 16);
            vp[544] = (bf16_t)(r.z & 0xffffu); vp[680] = (bf16_t)(r.z >> 16); vp[816] = (bf16_t)(r.w & 0xffffu); vp[952] = (bf16_t)(r.w >> 16);
            const int e = tid * 8 + it * 4096; *(uint4*)(Pv + (e >> 7) * 136 + (e & 127)) = it ? pr1 : pr0; }
        if (j < 7) { const bf16_t* xs = xc + (tokbase + sl) * 1536 + (hh + 1) * 64 + scg * 8; xr0 = *(const uint4*)xs; xr1 = *(const uint4*)(xs + 32);
            const bf16_t* ps = (const bf16_t*)(p.ws + OFF_SST) + ((size_t)bc * 16 + hh + 1) * 8192 + tid * 8; pr0 = *(const uint4*)ps; pr1 = *(const uint4*)(ps + 4096); }
        __syncthreads();
        const float* dth = dts + j * 128; const float* ach = acs + j * 128;
        const float al = ach[l], dsk = p.d_skip[layer * 16 + hh];
        uint2 zr[4];
#pragma unroll
        for (int pt = 0; pt < 4; ++pt) zr[pt] = *(const uint2*)(proj + tok * LDP + hh * 64 + pt * 16 + 4 * g4);
        f32x4 acc[4] = {F4ZERO, F4ZERO, F4ZERO, F4ZERO};
#pragma unroll
        for (int sp = 0; sp < 4; ++sp) {
            if (2 * sp <= w) {
                float m[8];
#pragma unroll
                for (int half = 0; half < 2; ++half) { const int T = 2 * sp + half;
                    const float4 av = *(const float4*)(ach + T * 16 + 4 * g4), dv = *(const float4*)(dth + T * 16 + 4 * g4);
                    const float aa[4] = {av.x, av.y, av.z, av.w}, dd[4] = {dv.x, dv.y, dv.z, dv.w};
#pragma unroll
                    for (int q = 0; q < 4; ++q) { const int s = T * 16 + 4 * g4 + q; float mv = (s <= l) ? cbt[T][q] * __expf(al - aa[q]) * dd[q] : 0.f; if (s == l) mv += dsk; m[half * 4 + q] = mv; } }
                const bf16x8 pf = as_bf8(pack8u(m));
#pragma unroll
                for (int pt = 0; pt < 4; ++pt) { const bf16_t* vp = Xt + (pt * 16 + lr) * 136 + (2 * sp) * 16 + 4 * g4;
                    acc[pt] = mfma16(cat4(*(const bf16x4*)vp, *(const bf16x4*)(vp + 16)), pf, acc[pt]); }
            }
        }
        f32x4 off[4] = {F4ZERO, F4ZERO, F4ZERO, F4ZERO};
#pragma unroll
        for (int ks = 0; ks < 4; ++ks)
#pragma unroll
            for (int pt = 0; pt < 4; ++pt) off[pt] = mfma16(*(const bf16x8*)(Pv + (pt * 16 + lr) * 136 + ks * 32 + g4 * 8), cf[ks], off[pt]);
        const float ea = __expf(al);
#pragma unroll
        for (int pt = 0; pt < 4; ++pt) { const int col = hh * 64 + pt * 16 + 4 * g4;
            float z[4]; unpack4(zr[pt], z);
            float yv[4];
#pragma unroll
            for (int q = 0; q < 4; ++q) { yv[q] = (acc[pt][q] + off[pt][q] * ea) * silu_f(z[q]); ssq += yv[q] * yv[q]; }
            *(uint2*)(y + tok * DM + col) = pack4u(yv[0], yv[1], yv[2], yv[3]); }
    }
    ssq += __shfl_xor(ssq, 16); ssq += __shfl_xor(ssq, 32);
    const float scale = rsqrtf(ssq * (1.0f / 512.0f) + 1e-6f);
    const float* nw = p.ssd_norm + layer * 1024;
#pragma unroll 1
    for (int j = 0; j < 8; ++j)
#pragma unroll
        for (int pt = 0; pt < 4; ++pt) { const int col = (8 * g + j) * 64 + pt * 16 + 4 * g4;
            float yv[4]; unpack4(*(const uint2*)(y + tok * DM + col), yv); const float4 nv = *(const float4*)(nw + col);
            *(uint2*)(y + tok * DM + col) = pack4u(yv[0] * scale * nv.x, yv[1] * scale * nv.y, yv[2] * scale * nv.z, yv[3] * scale * nv.w); }
    __syncthreads();
}

__device__ __forceinline__ void ssd_out_item2(const Params& p, int layer, int idx, unsigned char* shm) {
    int tid0_ = threadIdx.x; asm volatile("" : "+v"(tid0_)); const int tid = tid0_, lane = tid & 63, w = __builtin_amdgcn_readfirstlane(tid >> 6), lr = lane & 15, g4 = lane >> 4;
    const int g = idx & 1, bc = idx >> 1, hh = 8 * g + w;
    const size_t tokbase = (size_t)bc * 128;
    float* cbt = (float*)shm;
    float* dts = (float*)(shm + 36864); float* acs = dts + 8 * 128;
    float* ssqp = (float*)(shm + 45056);
    bf16_t* Cs = (bf16_t*)(shm + 49152);
    bf16_t* Bs = Cs + 128 * 136;
    bf16_t* xt = Bs + w * (64 * 40);
    const bf16_t* proj = (const bf16_t*)(p.ws + OFF_PROJ); const bf16_t* xc = (const bf16_t*)(p.ws + OFF_XC);
    bf16_t* y = (bf16_t*)(p.ws + OFF_Y);
    { float d0, d1, a0, a1;
      (void)head_acum((const float*)(p.ws + OFF_DT), tokbase, hh, -__expf(p.a_log[layer * 16 + hh]), lane, d0, d1, a0, a1);
      dts[w * 128 + 2 * lane] = d0; dts[w * 128 + 2 * lane + 1] = d1; acs[w * 128 + 2 * lane] = a0; acs[w * 128 + 2 * lane + 1] = a1; }
    stage_nat<128>(xc + 1280 + g * 128, 1536, tokbase, Cs, 136, tid);
    stage_nat<128>(xc + 1024 + g * 128, 1536, tokbase, Bs, 136, tid);
    bf16x8 pv[4][4];
    { const bf16_t* ps = (const bf16_t*)(p.ws + OFF_SST) + ((size_t)bc * 16 + hh) * 8192 + lr * 128 + g4 * 8;
#pragma unroll
      for (int ks = 0; ks < 4; ++ks)
#pragma unroll
          for (int pt = 0; pt < 4; ++pt) pv[ks][pt] = *(const bf16x8*)(ps + pt * 16 * 128 + ks * 32); }
    uint4 xraw[4][4];
    { const int xr = lane >> 1, xh = lane & 1;
#pragma unroll
      for (int sp = 0; sp < 4; ++sp) { const bf16_t* src = xc + (tokbase + sp * 32 + xr) * 1536 + hh * 64 + xh * 32;
#pragma unroll
          for (int i = 0; i < 4; ++i) xraw[sp][i] = *(const uint4*)(src + 8 * i); } }
    __syncthreads();
    { int t = 0;
#pragma unroll
      for (int lt = 0; lt < 8; ++lt)
#pragma unroll
          for (int st = 0; st <= lt; ++st, ++t) {
              if ((t & 7) == w) { f32x4 c = F4ZERO;
#pragma unroll
                  for (int ks = 0; ks < 4; ++ks) c = mfma16(*(const bf16x8*)(Bs + (st * 16 + lr) * 136 + ks * 32 + g4 * 8), *(const bf16x8*)(Cs + (lt * 16 + lr) * 136 + ks * 32 + g4 * 8), c);
                  *(f32x4*)(cbt + (t * 64 + lane) * 4) = c; } } }
    __syncthreads();
    bf16x8 xf[4][4];
    { const int xr = lane >> 1, xh = lane & 1;
#pragma unroll
      for (int sp = 0; sp < 4; ++sp) {
#pragma unroll
          for (int i = 0; i < 4; ++i) { bf16_t* vp = xt + (xh * 32 + 8 * i) * 40 + xr; const uint4 r = xraw[sp][i];
              vp[0] = (bf16_t)(r.x & 0xffffu); vp[40] = (bf16_t)(r.x >> 16); vp[80] = (bf16_t)(r.y & 0xffffu); vp[120] = (bf16_t)(r.y >> 16);
              vp[160] = (bf16_t)(r.z & 0xffffu); vp[200] = (bf16_t)(r.z >> 16); vp[240] = (bf16_t)(r.w & 0xffffu); vp[280] = (bf16_t)(r.w >> 16); }
          __builtin_amdgcn_fence(__ATOMIC_RELEASE, "wavefront"); __builtin_amdgcn_wave_barrier(); __builtin_amdgcn_fence(__ATOMIC_ACQUIRE, "wavefront");
#pragma unroll
          for (int pt = 0; pt < 4; ++pt) { const bf16_t* vp = xt + (pt * 16 + lr) * 40 + 4 * g4; xf[sp][pt] = cat4(*(const bf16x4*)vp, *(const bf16x4*)(vp + 16)); }
          __builtin_amdgcn_fence(__ATOMIC_RELEASE, "wavefront"); __builtin_amdgcn_wave_barrier(); __builtin_amdgcn_fence(__ATOMIC_ACQUIRE, "wavefront");
      } }
    const float dsk = p.d_skip[layer * 16 + hh];
    const float* dth = dts + w * 128; const float* ach = acs + w * 128;
    uint2 zn[4];
#pragma unroll
    for (int pt = 0; pt < 4; ++pt) zn[pt] = *(const uint2*)(proj + (tokbase + lr) * LDP + hh * 64 + pt * 16 + 4 * g4);
#pragma unroll
    for (int lt = 0; lt < 8; ++lt) {
        const int l = lt * 16 + lr; const size_t tok = tokbase + l;
        uint2 zr[4];
#pragma unroll
        for (int pt = 0; pt < 4; ++pt) zr[pt] = zn[pt];
        if (lt < 7) {
#pragma unroll
            for (int pt = 0; pt < 4; ++pt) zn[pt] = *(const uint2*)(proj + (tok + 16) * LDP + hh * 64 + pt * 16 + 4 * g4); }
        bf16x8 cf[4];
#pragma unroll
        for (int ks = 0; ks < 4; ++ks) cf[ks] = *(const bf16x8*)(Cs + l * 136 + ks * 32 + g4 * 8);
        const float al = ach[l];
        f32x4 acc[4] = {F4ZERO, F4ZERO, F4ZERO, F4ZERO};
#pragma unroll
        for (int sp = 0; sp <= lt / 2; ++sp) {
            float m[8];
#pragma unroll
            for (int half = 0; half < 2; ++half) { const int T = 2 * sp + half;
                f32x4 cv = F4ZERO; if (T <= lt) cv = *(const f32x4*)(cbt + ((lt * (lt + 1) / 2 + T) * 64 + lane) * 4);
                const float4 av = *(const float4*)(ach + T * 16 + 4 * g4), dv = *(const float4*)(dth + T * 16 + 4 * g4);
                const float aa[4] = {av.x, av.y, av.z, av.w}, dd[4] = {dv.x, dv.y, dv.z, dv.w};
#pragma unroll
                for (int q = 0; q < 4; ++q) { float mv;
                    if (T < lt) mv = cv[q] * __expf(al - aa[q]) * dd[q];
                    else if (T == lt) { const int s = T * 16 + 4 * g4 + q; mv = (s <= l) ? cv[q] * __expf(al - aa[q]) * dd[q] : 0.f; if (s == l) mv += dsk; }
                    else mv = 0.f;
                    m[half * 4 + q] = mv; } }
            const bf16x8 pf = as_bf8(pack8u(m));
#pragma unroll
            for (int pt = 0; pt < 4; ++pt) acc[pt] = mfma16(xf[sp][pt], pf, acc[pt]);
        }
        f32x4 off[4] = {F4ZERO, F4ZERO, F4ZERO, F4ZERO};
#pragma unroll
        for (int ks = 0; ks < 4; ++ks)
#pragma unroll
            for (int pt = 0; pt < 4; ++pt) off[pt] = mfma16(pv[ks][pt], cf[ks], off[pt]);
        const float ea = __expf(al);
        float ssq = 0.f;
#pragma unroll
        for (int pt = 0; pt < 4; ++pt) { const int col = hh * 64 + pt * 16 + 4 * g4;
            float z[4]; unpack4(zr[pt], z);
            float yv[4];
#pragma unroll
            for (int q = 0; q < 4; ++q) { yv[q] = (acc[pt][q] + off[pt][q] * ea) * silu_f(z[q]); ssq += yv[q] * yv[q]; }
            *(uint2*)(y + tok * DM + col) = pack4u(yv[0], yv[1], yv[2], yv[3]); }
        ssq += __shfl_xor(ssq, 16); ssq += __shfl_xor(ssq, 32);
        if (g4 == 0) ssqp[w * 128 + l] = ssq;
    }
    __syncthreads();
    const float* nw = p.ssd_norm + layer * 1024;
#pragma unroll 4
    for (int lt = 0; lt < 8; ++lt) {
        const int l = lt * 16 + lr; const size_t tok = tokbase + l;
        float tot = 0.f;
#pragma unroll
        for (int k = 0; k < 8; ++k) tot += ssqp[k * 128 + l];
        const float scale = rsqrtf(tot * (1.0f / 512.0f) + 1e-6f);
#pragma unroll
        for (int pt = 0; pt < 4; ++pt) { const int col = hh * 64 + pt * 16 + 4 * g4;
            float yv[4]; unpack4(*(const uint2*)(y + tok * DM + col), yv); const float4 nv = *(const float4*)(nw + col);
            *(uint2*)(y + tok * DM + col) = pack4u(yv[0] * scale * nv.x, yv[1] * scale * nv.y, yv[2] * scale * nv.z, yv[3] * scale * nv.w); }
    }
    __syncthreads();
}

__device__ __forceinline__ void ret_out_item(const Params& p, int layer, int idx, unsigned char* shm) {
    int tid0_ = threadIdx.x; asm volatile("" : "+v"(tid0_)); const int tid = tid0_, lane = tid & 63, w = __builtin_amdgcn_readfirstlane(tid >> 6), lr = lane & 15, g4 = lane >> 4;
    const int h = idx & 3, bc = idx >> 2;
    const size_t tokbase = (size_t)bc * 128;
    bf16_t* Qs = (bf16_t*)shm; bf16_t* Ks = Qs + 128 * 72; bf16_t* Vt = Ks + 128 * 72; bf16_t* Pt = Vt + 128 * 136;
    const bf16_t* proj = (const bf16_t*)(p.ws + OFF_PROJ);
    const float lg2 = log1pf(-exp2f(-5.0f - (float)h)) * 1.4426950408889634f;
    uint2 gr[8];
#pragma unroll
    for (int et = 0; et < 8; ++et) gr[et] = *(const uint2*)(proj + (tokbase + w * 16 + lr) * LDP + PRG + h * 128 + et * 16 + 4 * g4);
    { const float* cosT = (const float*)(p.ws + OFF_ROPE); const float* sinT = cosT + 8192 * 32;
      const int sub = tid & 7, r0 = tid >> 3, t0 = (bc & 63) * 128;
      uint4 rq[2], rk[2];
#pragma unroll
      for (int it = 0; it < 2; ++it) { const bf16_t* src = proj + (tokbase + r0 + it * 64) * LDP + h * 64 + sub * 8; rq[it] = *(const uint4*)(src + PRQ); rk[it] = *(const uint4*)(src + PRK); }
#pragma unroll
      for (int it = 0; it < 2; ++it) { float v[8];
          unpack8(rq[it], v); rope8(v, cosT, sinT, t0 + r0 + it * 64, sub, 1.0f); *(uint4*)(Qs + (r0 + it * 64) * 72 + sub * 8) = pack8u(v);
          unpack8(rk[it], v); rope8(v, cosT, sinT, t0 + r0 + it * 64, sub, 0.125f); *(uint4*)(Ks + (r0 + it * 64) * 72 + sub * 8) = pack8u(v); } }
    stage_tr<128>(proj + PRV + h * 128, LDP, tokbase, Vt, 136, nullptr, tid);
    { const float* src = (const float*)(p.ws + OFF_RST) + ((size_t)bc * 4 + h) * 8192 + (tid >> 2) * 64 + (tid & 3) * 16;
      float v[16];
#pragma unroll
      for (int q = 0; q < 4; ++q) { const float4 f = *(const float4*)(src + 4 * q); v[4 * q] = f.x; v[4 * q + 1] = f.y; v[4 * q + 2] = f.z; v[4 * q + 3] = f.w; }
      bf16_t* dp = Pt + (tid >> 2) * 72 + (tid & 3) * 16;
      *(uint4*)dp = pack8u(v); *(uint4*)(dp + 8) = pack8u(v + 8); }
    __syncthreads();
    const int l = w * 16 + lr;
    bf16x8 qf[2];
#pragma unroll
    for (int ks = 0; ks < 2; ++ks) qf[ks] = *(const bf16x8*)(Qs + l * 72 + ks * 32 + g4 * 8);
    f32x4 o[8], cr[8];
#pragma unroll
    for (int et = 0; et < 8; ++et) { o[et] = F4ZERO; cr[et] = F4ZERO; }
#pragma unroll
    for (int sp = 0; sp < 4; ++sp) {
        if (2 * sp <= w) {
            float m[8];
#pragma unroll
            for (int half = 0; half < 2; ++half) { const int T = 2 * sp + half; f32x4 sc = F4ZERO;
                if (T <= w) {
#pragma unroll
                    for (int ks = 0; ks < 2; ++ks) sc = mfma16(*(const bf16x8*)(Ks + (T * 16 + lr) * 72 + ks * 32 + g4 * 8), qf[ks], sc); }
#pragma unroll
                for (int q = 0; q < 4; ++q) { const int s = T * 16 + 4 * g4 + q; const float e = sc[q] * __builtin_amdgcn_exp2f((float)(l - s) * lg2); m[half * 4 + q] = (T < w) ? e : ((s <= l) ? e : 0.f); } }
            const bf16x8 pf = as_bf8(pack8u(m));
#pragma unroll
            for (int et = 0; et < 8; ++et) { const bf16_t* vp = Vt + (et * 16 + lr) * 136 + (2 * sp) * 16 + 4 * g4;
                o[et] = mfma16(cat4(*(const bf16x4*)vp, *(const bf16x4*)(vp + 16)), pf, o[et]); }
        }
    }
#pragma unroll
    for (int ks = 0; ks < 2; ++ks)
#pragma unroll
        for (int et = 0; et < 8; ++et) cr[et] = mfma16(*(const bf16x8*)(Pt + (et * 16 + lr) * 72 + ks * 32 + g4 * 8), qf[ks], cr[et]);
    const float gl = __builtin_amdgcn_exp2f((float)(l + 1) * lg2);
    float ssq = 0.f;
#pragma unroll
    for (int et = 0; et < 8; ++et)
#pragma unroll
        for (int q = 0; q < 4; ++q) { o[et][q] += cr[et][q] * gl; ssq += o[et][q] * o[et][q]; }
    ssq += __shfl_xor(ssq, 16); ssq += __shfl_xor(ssq, 32);
    const float scale = rsqrtf(ssq * (1.0f / 128.0f) + 1e-6f);
    const size_t tok = tokbase + l;
    const float* nw = p.ret_norm + layer * 512;
    bf16_t* y = (bf16_t*)(p.ws + OFF_Y);
#pragma unroll
    for (int et = 0; et < 8; ++et) { const int col = h * 128 + et * 16 + 4 * g4;
        float gt[4]; unpack4(gr[et], gt); const float4 nv = *(const float4*)(nw + col);
        *(uint2*)(y + tok * DM + 1536 + col) = pack4u(o[et][0] * scale * nv.x * silu_f(gt[0]), o[et][1] * scale * nv.y * silu_f(gt[1]), o[et][2] * scale * nv.z * silu_f(gt[2]), o[et][3] * scale * nv.w * silu_f(gt[3])); }
    __syncthreads();
}

#define KA __attribute__((address_space(4)))
__device__ __forceinline__ Params ld_params() {
    const KA Params* pp = (const KA Params*)__builtin_amdgcn_kernarg_segment_ptr();
    asm volatile("" : "+s"(pp));
    Params q; q.x = pp->x; q.ln_mix = pp->ln_mix; q.w_in = pp->w_in; q.conv_w = pp->conv_w; q.conv_b = pp->conv_b; q.dt_bias = pp->dt_bias; q.a_log = pp->a_log; q.d_skip = pp->d_skip; q.ssd_norm = pp->ssd_norm;
    q.q_norm = pp->q_norm; q.k_norm = pp->k_norm; q.ret_norm = pp->ret_norm; q.w_out = pp->w_out; q.ln_ffn = pp->ln_ffn; q.w_gate = pp->w_gate; q.w_up = pp->w_up; q.w_down = pp->w_down; q.out = pp->out; q.ws = pp->ws;
    return q;
}
#ifndef PROBE_MASK
#define PROBE_MASK 0
#endif
#ifndef PROBE_K
#define PROBE_K 2
#endif
#define TICK(id) do { if (PROBE_MASK & (1 << (id))) pt0 = __builtin_amdgcn_s_memrealtime(); } while (0)
#define TOCK(id) do { if (PROBE_MASK & (1 << (id))) pacc += __builtin_amdgcn_s_memrealtime() - pt0; } while (0)
__global__ __launch_bounds__(512, 2) void hybrid_fwd(Params p_unused) {
    extern __shared__ __attribute__((aligned(16))) unsigned char shm[];
    cg::grid_group grid = cg::this_grid();
    unsigned long long pt0 = 0, pacc = 0; (void)pt0;
    volatile XLAS unsigned* bst = (volatile XLAS unsigned*)(shm + 131072);
    if (threadIdx.x == 0) { bst[0] = 0u; bst[1] = 0u; }
    __syncthreads();
    const XcdBarrier xb = xcd_barrier_post((unsigned*)(ld_params().ws + OFF_BAR), bst);
    if (threadIdx.x == 0) bst[2] = xb_add((unsigned*)(ld_params().ws + OFF_BAR) + 16 + xb.x, 1u);
#define GSYNC() xcd_barrier(xb)
    if ((PROBE_MASK & (1 << 13)) && threadIdx.x == 0 && xb.x != (blockIdx.x & 7u)) atomicAdd((unsigned*)(ld_params().ws + OFF_BAR), 1u);
    { const Params p = ld_params(); phase_prep(p, shm); }
    { const Params p = ld_params(); phase_resid<true, true>(p.x, (bf16_t*)(p.ws + OFF_HN), nullptr, (bf16_t*)(p.ws + OFF_Y), p.ln_mix, p.w_in, p.dt_bias, (float*)(p.ws + OFF_DT), shm); }
    grid.sync();
    if (threadIdx.x == 0) { unsigned* bar = (unsigned*)(ld_params().ws + OFF_BAR); bool uni = (gridDim.x & 7u) == 0u;
        for (unsigned j = 0; j < 16; ++j) { const unsigned c = xb_ld(&bar[XB_XCNT(j)]); uni = uni && (c == (j < 8 ? gridDim.x / 8u : 0u)); }
        bst[3] = uni ? (bst[2] * 8u + xb.x) : blockIdx.x; }
    __syncthreads();
    const int vb = (int)bst[3];
    if ((PROBE_MASK & (1 << 14)) && threadIdx.x == 0 && vb != (int)blockIdx.x) atomicAdd((unsigned*)(ld_params().ws + OFF_BAR) + 1, 1u);
#pragma unroll 1
    for (int layer = 0; layer < 2; ++layer) {
        if (layer > 0) {
            TICK(1);
            { const Params p = ld_params(); phase_resid<true, false>(nullptr, (bf16_t*)(p.ws + OFF_HN), nullptr, (bf16_t*)(p.ws + OFF_Y), p.ln_mix + layer * DM, p.w_in + (size_t)layer * DM * INW, p.dt_bias + layer * 16, (float*)(p.ws + OFF_DT), shm); }
            GSYNC();
            TOCK(1);
        }
        TICK(2);
        { const Params p = ld_params(); pg8::EpiProj E; E.O = (bf16_t*)(p.ws + OFF_PROJ); E.ldc = LDP; E.rs = nullptr; run_gemm(shm, (const bf16_t*)(p.ws + OFF_Y), (const bf16_t*)(p.ws + OFF_WIN + layer * SZ_WIN), NTOK, 5632, DM, E, vb); }
        GSYNC();
        TOCK(2);
        TICK(3);
        { const Params p = ld_params(); phase_pre(p, layer); }
        GSYNC();
        TOCK(3);
        TICK(4);
        { const Params p = ld_params(); const int per = (6144 + (int)gridDim.x - 1) / (int)gridDim.x, u0 = (int)blockIdx.x * per; int cnt = 6144 - u0; cnt = cnt < per ? cnt : per;
          att_run(p, u0, cnt, shm); }
        { const Params p = ld_params();
          for (int it = blockIdx.x; it < 1536; it += gridDim.x) {
            if (it < 512) ssd_state_item(p, layer, it, shm);
            else ret_state_item(p, it - 512, shm);
          } }
        GSYNC();
        TOCK(4);
        TICK(5);
        { const Params p = ld_params(); phase_scan(p); }
        GSYNC();
        TOCK(5);
        TICK(6);
        { const Params p = ld_params();
          for (int it = blockIdx.x; it < 1536; it += gridDim.x) {
            if (it < 512) { for (int rep = 0; rep < REP_SO; ++rep) SSD_OUT(p, layer, it, shm); }
            else { for (int rep = 0; rep < REP_RO; ++rep) ret_out_item(p, layer, it - 512, shm); }
          } }
        GSYNC();
        TOCK(6);
        TICK(7);
        { const Params p = ld_params(); pg8::EpiAccB E; E.X = (bf16_t*)(p.ws + OFF_HN); E.ldc = DM; run_gemm(shm, (const bf16_t*)(p.ws + OFF_Y), (const bf16_t*)(p.ws + OFF_WOUT + layer * SZ_WOUT), NTOK, DM, DM, E, vb); }
        GSYNC();
        TOCK(7);
        TICK(8);
        { const Params p = ld_params();
          phase_resid<false, false>(nullptr, (bf16_t*)(p.ws + OFF_HN), nullptr, (bf16_t*)(p.ws + OFF_Y), nullptr, nullptr, nullptr, nullptr, shm); }
        GSYNC();
        TOCK(8);
        TICK(9);
        unsigned long long pc0 = 0, pr0 = 0; if (PROBE_MASK & (1 << 15)) { pc0 = clock64(); pr0 = __builtin_amdgcn_s_memrealtime(); }
        { const Params p = ld_params(); pg8::EpiSwiGLU E; E.H = (bf16_t*)(p.ws + OFF_PROJ); E.ldc = DFF; E.rs = nullptr; run_gemm(shm, (const bf16_t*)(p.ws + OFF_Y), (const bf16_t*)(p.ws + OFF_WGU + layer * SZ_WGU), NTOK, 2 * DFF, DM, E, vb, &pacc); }
        if (PROBE_MASK & (1 << 15)) { const unsigned long long dc = clock64() - pc0, dr = __builtin_amdgcn_s_memrealtime() - pr0; pacc = (layer == 1) ? (dc * 100ull / dr) * 50ull : 0ull; }
        GSYNC();
        TOCK(9);
        TICK(10);
        if (layer == 0) { const Params p = ld_params(); pg8::EpiAccB E; E.X = (bf16_t*)(p.ws + OFF_HN); E.ldc = DM; run_gemm(shm, (const bf16_t*)(p.ws + OFF_PROJ), (const bf16_t*)(p.ws + OFF_WDN + layer * SZ_WDN), NTOK, DM, DFF, E, vb); GSYNC(); }
        else { const Params p = ld_params(); pg8::EpiRes E; E.C = p.out; E.R = (const bf16_t*)(p.ws + OFF_HN); E.ldc = DM; run_gemm(shm, (const bf16_t*)(p.ws + OFF_PROJ), (const bf16_t*)(p.ws + OFF_WDN + layer * SZ_WDN), NTOK, DM, DFF, E, vb); }
        TOCK(10);
    }
    if ((PROBE_MASK & (1 << 13)) && blockIdx.x == 0 && threadIdx.x == 0) pacc = 1000ull * __hip_atomic_load((unsigned*)(ld_params().ws + OFF_BAR), __ATOMIC_RELAXED, __HIP_MEMORY_SCOPE_AGENT);
    if ((PROBE_MASK & (1 << 14)) && blockIdx.x == 0 && threadIdx.x == 0) pacc = 1000ull * __hip_atomic_load((unsigned*)(ld_params().ws + OFF_BAR) + 1, __ATOMIC_RELAXED, __HIP_MEMORY_SCOPE_AGENT);
    if (PROBE_MASK && blockIdx.x == 0 && threadIdx.x == 0) { const unsigned long long ts = __builtin_amdgcn_s_memrealtime(); while (__builtin_amdgcn_s_memrealtime() - ts < (unsigned long long)PROBE_K * pacc) __builtin_amdgcn_s_sleep(8); }
}

extern "C" void kernel_launch(void* const* d_in, const int* in_sizes, int n_in, void* d_out, int out_size, void* d_ws, size_t ws_size, hipStream_t stream) {
    static int grid = 0;
    if (grid == 0) {
        if (n_in != 17 || ws_size < WS_END) { fprintf(stderr, "kernel_launch: unexpected n_in %d / ws_size %zu (need %zu)\n", n_in, ws_size, (size_t)WS_END); grid = -1; return; }
        int dev = 0, cus = 0, per_cu = 0;
        (void)hipGetDevice(&dev); (void)hipDeviceGetAttribute(&cus, hipDeviceAttributeMultiprocessorCount, dev);
        if (hipFuncSetAttribute((const void*)hybrid_fwd, hipFuncAttributeMaxDynamicSharedMemorySize, LDS_BYTES) != hipSuccess) { fprintf(stderr, "kernel_launch: hipFuncSetAttribute failed\n"); grid = -1; return; }
        if (hipOccupancyMaxActiveBlocksPerMultiprocessor(&per_cu, (const void*)hybrid_fwd, 512, LDS_BYTES) != hipSuccess || per_cu < 1) { fprintf(stderr, "kernel_launch: occupancy query says %d\n", per_cu); per_cu = 1; }
        (void)hipGetLastError();
        grid = cus * per_cu;
    }
    if (grid < 0) return;
    Params p{};
    const float** f = (const float**)&p;
    for (int i = 0; i < 17; ++i) f[i] = (const float*)d_in[i];
    p.out = (float*)d_out; p.ws = (unsigned char*)d_ws;
    if (hipMemsetAsync((unsigned char*)d_ws + OFF_BAR, 0, (size_t)XCD_BAR_WORDS * 4, stream) != hipSuccess) { fprintf(stderr, "kernel_launch: memset of the barrier words failed\n"); return; }
    void* args[] = {&p};
    const hipError_t e = hipLaunchCooperativeKernel((const void*)hybrid_fwd, dim3(grid), dim3(512), args, LDS_BYTES, stream);
    if (e != hipSuccess) fprintf(stderr, "kernel_launch: cooperative launch failed: %s (grid %d)\n", hipGetErrorString(e), grid);
}
```
